# Optimizing an MI355X kernel written in HIP

```python
import math
import jax, jax.numpy as jnp
from jax import lax
import numpy as np

D_MODEL = 1024
BATCH = 8
SEQ = 4096
DEPTH = 1

PLE_DIM = 256
SSM_WIDTH = D_MODEL // 2
SSM_GROUP = 16
SSM_GROUPS = SSM_WIDTH // SSM_GROUP
SSM_STATE = 64
ATTN_WIDTH = D_MODEL - SSM_WIDTH
N_HEADS = 4
HEAD_DIM = 64
V_HEAD_DIM = 2 * HEAD_DIM
ROT_DIM = HEAD_DIM // 4
ROPE_THETA = 500000.0
Q_BLOCK = 128
EPS = 1e-6
IN_COLS = 2 * SSM_WIDTH + 4 * ATTN_WIDTH
DT_MIN = 0.001
DT_MAX = 0.1

kernel_name = "hymba_s5_diffattn_ple_block"


def rmsnorm(x, w):
    xf = x.astype(jnp.float32)
    y = xf * lax.rsqrt(jnp.mean(xf * xf, axis=-1, keepdims=True) + EPS)
    return (y * w.astype(jnp.float32)).astype(x.dtype)


def partial_rope(t, cos, sin):
    half = ROT_DIM // 2
    t1 = t[..., :half].astype(jnp.float32)
    t2 = t[..., half:ROT_DIM].astype(jnp.float32)
    rot = jnp.concatenate([t1 * cos - t2 * sin, t2 * cos + t1 * sin], axis=-1)
    return jnp.concatenate([rot.astype(t.dtype), t[..., ROT_DIM:]], axis=-1)


def s5_branch(u, lam_re, lam_im, log_dt, b_re, b_im, c_re, c_im, d_skip, glu_w, glu_b):
    f32 = jnp.float32
    bsz, s_len, _ = u.shape
    uf = u.astype(f32)
    ug = uf.reshape(bsz, s_len, SSM_GROUPS, SSM_GROUP)
    lr = lam_re.astype(f32)
    li = lam_im.astype(f32)
    dt = jnp.exp(log_dt.astype(f32))[:, None]
    mag = jnp.exp(lr * dt)
    ab_re = mag * jnp.cos(li * dt)
    ab_im = mag * jnp.sin(li * dt)
    nr = ab_re - 1.0
    ni = ab_im
    den = lr * lr + li * li
    coef_re = (nr * lr + ni * li) / den
    coef_im = (ni * lr - nr * li) / den
    br = b_re.astype(f32)
    bi = b_im.astype(f32)
    bb_re = coef_re[..., None] * br - coef_im[..., None] * bi
    bb_im = coef_re[..., None] * bi + coef_im[..., None] * br
    bu_re = jnp.einsum('bsgp,gnp->bsgn', ug, bb_re)
    bu_im = jnp.einsum('bsgp,gnp->bsgn', ug, bb_im)
    a_re = jnp.broadcast_to(ab_re, bu_re.shape)
    a_im = jnp.broadcast_to(ab_im, bu_im.shape)

    def combine(e1, e2):
        a1r, a1i, b1r, b1i = e1
        a2r, a2i, b2r, b2i = e2
        ar = a1r * a2r - a1i * a2i
        ai = a1r * a2i + a1i * a2r
        nbr = a2r * b1r - a2i * b1i + b2r
        nbi = a2r * b1i + a2i * b1r + b2i
        return (ar, ai, nbr, nbi)

    _, _, xr, xi = lax.associative_scan(combine, (a_re, a_im, bu_re, bu_im), axis=1)
    y = (jnp.einsum('bsgn,gpn->bsgp', xr, c_re.astype(f32))
         - jnp.einsum('bsgn,gpn->bsgp', xi, c_im.astype(f32)))
    y = y.reshape(bsz, s_len, SSM_WIDTH) + d_skip.astype(f32) * uf
    y = jax.nn.gelu(y)
    y = y * jax.nn.sigmoid(y @ glu_w.astype(f32) + glu_b.astype(f32))
    return y


def diff_attention(q, k, v, positions, q_norm_w, k_norm_w, lq1, lk1, lq2, lk2,
                   subln_w, lambda_init):
    f32 = jnp.float32
    bsz, s_len, _ = q.shape
    n_blocks = s_len // Q_BLOCK
    q = q.reshape(bsz, s_len, N_HEADS, 2, HEAD_DIM)
    k = k.reshape(bsz, s_len, N_HEADS, 2, HEAD_DIM)
    v = v.reshape(bsz, s_len, N_HEADS, V_HEAD_DIM)
    inv_freq = ROPE_THETA ** (-jnp.arange(0, ROT_DIM, 2, dtype=f32) / ROT_DIM)
    ang = positions.astype(f32)[..., None] * inv_freq
    cos = jnp.cos(ang)[:, :, None, None, :]
    sin = jnp.sin(ang)[:, :, None, None, :]
    q = partial_rope(rmsnorm(q, q_norm_w), cos, sin).astype(f32) * (HEAD_DIM ** -0.5)
    k = partial_rope(rmsnorm(k, k_norm_w), cos, sin).astype(f32)
    lam = (jnp.exp(jnp.sum(lq1.astype(f32) * lk1.astype(f32)))
           - jnp.exp(jnp.sum(lq2.astype(f32) * lk2.astype(f32))) + lambda_init)

    qb = q.reshape(bsz, n_blocks, Q_BLOCK, N_HEADS, 2, HEAD_DIM).transpose(1, 0, 3, 4, 2, 5)
    kt = k.transpose(0, 2, 3, 1, 4)
    vt = v.astype(f32).transpose(0, 2, 1, 3)
    key_idx = jnp.arange(s_len)
    starts = jnp.arange(n_blocks) * Q_BLOCK

    def block(args):
        qblk, start = args
        sc = jnp.einsum('bhcqd,bhckd->bhcqk', qblk, kt)
        q_idx = start + jnp.arange(Q_BLOCK)
        mask = key_idx[None, :] <= q_idx[:, None]
        sc = jnp.where(mask, sc, jnp.finfo(f32).min)
        pr = jax.nn.softmax(sc, axis=-1)
        w = pr[:, :, 0] - lam * pr[:, :, 1]
        return jnp.einsum('bhqk,bhkd->bhqd', w, vt)

    out = lax.map(block, (qb, starts))
    out = out.transpose(1, 0, 3, 2, 4).reshape(bsz, s_len, N_HEADS, V_HEAD_DIM)
    out = rmsnorm(out, subln_w) * (1.0 - lambda_init)
    return out.reshape(bsz, s_len, ATTN_WIDTH)


def setup_inputs(seed: int = 0) -> dict:
    key = jax.random.key(seed)
    ks = jax.random.split(key, 24)
    f32 = jnp.float32
    nrm = lambda k, shape, scale: (jax.random.normal(k, shape, f32) * scale)
    x = jax.random.normal(ks[0], (BATCH, SEQ, D_MODEL), f32)
    p = jax.random.normal(ks[1], (DEPTH, BATCH, SEQ, PLE_DIM), f32)
    positions = jnp.broadcast_to(jnp.arange(SEQ, dtype=jnp.int32)[None, :], (BATCH, SEQ))
    norm_w = 1.0 + nrm(ks[2], (DEPTH, D_MODEL), 0.02)
    w_in = nrm(ks[3], (DEPTH, D_MODEL, IN_COLS), D_MODEL ** -0.5)
    n_idx = jnp.arange(SSM_STATE, dtype=f32)
    ssm_lambda_re = -0.5 + nrm(ks[4], (DEPTH, SSM_GROUPS, SSM_STATE), 0.01)
    ssm_lambda_im = math.pi * n_idx + nrm(ks[5], (DEPTH, SSM_GROUPS, SSM_STATE), 0.01)
    ssm_log_dt = jax.random.uniform(ks[6], (DEPTH, SSM_GROUPS), f32,
                                    math.log(DT_MIN), math.log(DT_MAX))
    ssm_b_re = nrm(ks[7], (DEPTH, SSM_GROUPS, SSM_STATE, SSM_GROUP), (2 * SSM_GROUP) ** -0.5)
    ssm_b_im = nrm(ks[8], (DEPTH, SSM_GROUPS, SSM_STATE, SSM_GROUP), (2 * SSM_GROUP) ** -0.5)
    ssm_c_re = nrm(ks[9], (DEPTH, SSM_GROUPS, SSM_GROUP, SSM_STATE), SSM_STATE ** -0.5)
    ssm_c_im = nrm(ks[10], (DEPTH, SSM_GROUPS, SSM_GROUP, SSM_STATE), SSM_STATE ** -0.5)
    ssm_d = nrm(ks[11], (DEPTH, SSM_WIDTH), 1.0)
    glu_w = nrm(ks[12], (DEPTH, SSM_WIDTH, SSM_WIDTH), SSM_WIDTH ** -0.5)
    glu_b = nrm(ks[13], (DEPTH, SSM_WIDTH), 0.01)
    q_norm_w = 1.0 + nrm(ks[14], (DEPTH, HEAD_DIM), 0.02)
    k_norm_w = 1.0 + nrm(ks[15], (DEPTH, HEAD_DIM), 0.02)
    lambda_q1 = nrm(ks[16], (DEPTH, HEAD_DIM), 0.1)
    lambda_k1 = nrm(ks[17], (DEPTH, HEAD_DIM), 0.1)
    lambda_q2 = nrm(ks[18], (DEPTH, HEAD_DIM), 0.1)
    lambda_k2 = nrm(ks[19], (DEPTH, HEAD_DIM), 0.1)
    subln_w = 1.0 + nrm(ks[20], (DEPTH, V_HEAD_DIM), 0.02)
    w_out = nrm(ks[21], (DEPTH, SSM_WIDTH + ATTN_WIDTH, D_MODEL), (SSM_WIDTH + ATTN_WIDTH) ** -0.5)
    ple_w_proj = nrm(ks[22], (DEPTH, PLE_DIM, D_MODEL), 0.5 * PLE_DIM ** -0.5)
    ple_w_gate = nrm(ks[23], (DEPTH, D_MODEL, D_MODEL), D_MODEL ** -0.5)
    return {
        "x": x, "p": p, "positions": positions, "norm_w": norm_w, "w_in": w_in,
        "ssm_lambda_re": ssm_lambda_re, "ssm_lambda_im": ssm_lambda_im,
        "ssm_log_dt": ssm_log_dt, "ssm_b_re": ssm_b_re, "ssm_b_im": ssm_b_im,
        "ssm_c_re": ssm_c_re, "ssm_c_im": ssm_c_im, "ssm_d": ssm_d,
        "glu_w": glu_w, "glu_b": glu_b, "q_norm_w": q_norm_w, "k_norm_w": k_norm_w,
        "lambda_q1": lambda_q1, "lambda_k1": lambda_k1, "lambda_q2": lambda_q2,
        "lambda_k2": lambda_k2, "subln_w": subln_w, "w_out": w_out,
        "ple_w_proj": ple_w_proj, "ple_w_gate": ple_w_gate,
    }


def reference(x, p, positions, norm_w, w_in, ssm_lambda_re, ssm_lambda_im, ssm_log_dt,
              ssm_b_re, ssm_b_im, ssm_c_re, ssm_c_im, ssm_d, glu_w, glu_b,
              q_norm_w, k_norm_w, lambda_q1, lambda_k1, lambda_q2, lambda_k2,
              subln_w, w_out, ple_w_proj, ple_w_gate):
    splits = [SSM_WIDTH, 2 * SSM_WIDTH, 2 * SSM_WIDTH + ATTN_WIDTH,
              2 * SSM_WIDTH + 2 * ATTN_WIDTH, 2 * SSM_WIDTH + 3 * ATTN_WIDTH]
    for i in range(DEPTH):
        lambda_init = 0.8 - 0.6 * math.exp(-0.3 * i)
        h = rmsnorm(x, norm_w[i])
        proj = h @ w_in[i]
        u, z_s, q, k, v, z_a = jnp.split(proj, splits, axis=-1)
        y_s = s5_branch(u, ssm_lambda_re[i], ssm_lambda_im[i], ssm_log_dt[i],
                        ssm_b_re[i], ssm_b_im[i], ssm_c_re[i], ssm_c_im[i],
                        ssm_d[i], glu_w[i], glu_b[i])
        y_s = (y_s * jax.nn.silu(z_s.astype(jnp.float32))).astype(x.dtype)
        y_a = diff_attention(q, k, v, positions, q_norm_w[i], k_norm_w[i],
                             lambda_q1[i], lambda_k1[i], lambda_q2[i], lambda_k2[i],
                             subln_w[i], lambda_init)
        y_a = (y_a * jax.nn.silu(z_a.astype(jnp.float32))).astype(x.dtype)
        x = x + jnp.concatenate([y_s, y_a], axis=-1) @ w_out[i]
        gate = jax.nn.sigmoid((x @ ple_w_gate[i]).astype(jnp.float32)).astype(x.dtype)
        x = x + gate * (p[i] @ ple_w_proj[i])
    return x
```

```cpp
#include <hip/hip_runtime.h>
#include <hip/hip_cooperative_groups.h>
#include <stdint.h>
#include <cstdio>
namespace cg = cooperative_groups;

typedef unsigned short bf16_t;
typedef short bf16x8 __attribute__((ext_vector_type(8)));
typedef float f32x4 __attribute__((ext_vector_type(4)));
typedef float f32x16 __attribute__((ext_vector_type(16)));
typedef unsigned u32x4 __attribute__((ext_vector_type(4)));
typedef unsigned u32x2 __attribute__((ext_vector_type(2)));

#define NTOK 32768
#define SEQ 4096
#define DM 1024
#define INC 3072
#define NTHR 512
#define LDS_BYTES 139264
#define LOG2E 1.4426950408889634f

struct Params {
  const float *x, *p; const int* pos;
  const float *norm_w, *w_in, *lam_re, *lam_im, *log_dt, *b_re, *b_im, *c_re, *c_im, *ssm_d, *glu_w, *glu_b,
      *qnw, *knw, *lq1, *lk1, *lq2, *lk2, *subln_w, *w_out, *wp, *wg;
  float* out;
  float* rope; unsigned* barw;
  bf16_t *Hb, *WtIn, *WtGlu, *WtOut, *WtP, *WtG, *Pb, *U, *Zs, *Qb, *Kb, *Vt, *Za, *Yg, *Ycat, *X1b, *PP;
};

#define DI __device__ __forceinline__
DI unsigned pk_bf16(float lo, float hi) { unsigned r; asm("v_cvt_pk_bf16_f32 %0, %1, %2" : "=v"(r) : "v"(lo), "v"(hi)); return r; }
DI float bflo(unsigned w) { return __uint_as_float(w << 16); }
DI float bfhi(unsigned w) { return __uint_as_float(w & 0xffff0000u); }
DI float bf2f(bf16_t v) { return __uint_as_float(((unsigned)v) << 16); }
DI float sigmoidf_(float v) { return __builtin_amdgcn_rcpf(1.0f + __builtin_amdgcn_exp2f(-LOG2E * v)); }
DI float siluf_(float v) { return v * __builtin_amdgcn_rcpf(1.0f + __builtin_amdgcn_exp2f(-LOG2E * v)); }
DI float gelu_tanh(float v) { float u = 0.7978845608028654f * (v + 0.044715f * v * v * v); return v * __builtin_amdgcn_rcpf(1.0f + __builtin_amdgcn_exp2f(-2.0f * LOG2E * u)); }
DI void store16bf(bf16_t* dst, const f32x4 (&v)[4]) {
  u32x4 a, b;
  a.x = pk_bf16(v[0][0], v[0][1]); a.y = pk_bf16(v[0][2], v[0][3]); a.z = pk_bf16(v[1][0], v[1][1]); a.w = pk_bf16(v[1][2], v[1][3]);
  b.x = pk_bf16(v[2][0], v[2][1]); b.y = pk_bf16(v[2][2], v[2][3]); b.z = pk_bf16(v[3][0], v[3][1]); b.w = pk_bf16(v[3][2], v[3][3]);
  *(u32x4*)dst = a; *(u32x4*)(dst + 8) = b;
}
DI void cvt16bf(const u32x4 a, const u32x4 b, f32x4 (&v)[4]) {
  v[0] = (f32x4){bflo(a.x), bfhi(a.x), bflo(a.y), bfhi(a.y)}; v[1] = (f32x4){bflo(a.z), bfhi(a.z), bflo(a.w), bfhi(a.w)};
  v[2] = (f32x4){bflo(b.x), bfhi(b.x), bflo(b.y), bfhi(b.y)}; v[3] = (f32x4){bflo(b.z), bfhi(b.z), bflo(b.w), bfhi(b.w)};
}
DI void load16bf(const bf16_t* src, f32x4 (&v)[4]) {
  u32x4 a = *(const u32x4*)src, b = *(const u32x4*)(src + 8);
  v[0] = (f32x4){bflo(a.x), bfhi(a.x), bflo(a.y), bfhi(a.y)}; v[1] = (f32x4){bflo(a.z), bfhi(a.z), bflo(a.w), bfhi(a.w)};
  v[2] = (f32x4){bflo(b.x), bfhi(b.x), bflo(b.y), bfhi(b.y)}; v[3] = (f32x4){bflo(b.z), bfhi(b.z), bflo(b.w), bfhi(b.w)};
}

#define XB_TMO      128
#define XB_XCNT(j)  (256  + 64 * (j))
#define XB_XSUB(j)  (1280 + 64 * (j))
#define XB_XGEN(j)  (2304 + 64 * (j))
#define XB_TOP      3328
#define XB_TOPGEN   3392
#define XCD_BAR_WORDS 3456
#define XB_SPIN_CAP (1u << 18)
#define LAS __attribute__((address_space(3)))
DI unsigned xb_ld(unsigned* p) { return __hip_atomic_load(p, __ATOMIC_RELAXED, __HIP_MEMORY_SCOPE_AGENT); }
DI unsigned xb_add(unsigned* p, unsigned v) { return __hip_atomic_fetch_add(p, v, __ATOMIC_RELAXED, __HIP_MEMORY_SCOPE_AGENT); }
DI unsigned xb_xcc_id() { return (unsigned)__builtin_amdgcn_s_getreg((3 << 11) | 20) & 0xFu; }
#define XB_SPIN(cond, bar) do { unsigned _sp = 0; while (cond) { __builtin_amdgcn_s_sleep(1); \
    if ((++_sp & 255u) == 0u) { if (xb_ld(&(bar)[XB_TMO])) break; if (_sp > XB_SPIN_CAP) { atomicAdd(&(bar)[XB_TMO], 1u); break; } } } } while (0)
struct XcdBarrier { unsigned* bar; unsigned x; volatile LAS unsigned* st; };
DI XcdBarrier xcd_barrier_post(unsigned* bar, volatile LAS unsigned* st) {
  XcdBarrier b; b.bar = bar; b.x = xb_xcc_id(); b.st = st;
  if (threadIdx.x == 0) (void)xb_add(&bar[XB_XCNT(b.x)], 1u);
  return b;
}
DI void xcd_barrier_complete(unsigned* bar, unsigned x, unsigned& nloc, unsigned& nx) {
  const unsigned G = gridDim.x * gridDim.y * gridDim.z;
  unsigned sum, cnt, mine, sp = 0u;
  for (;;) {
    sum = 0u; cnt = 0u; mine = 0u;
#pragma unroll
    for (unsigned j = 0; j < 16; ++j) { const unsigned c = xb_ld(&bar[XB_XCNT(j)]); sum += c; cnt += (c > 0u) ? 1u : 0u; mine = (j == x) ? c : mine; }
    if (sum == G) break;
    __builtin_amdgcn_s_sleep(1);
    if ((++sp & 255u) == 0u) { if (xb_ld(&bar[XB_TMO])) break; if (sp > XB_SPIN_CAP) { atomicAdd(&bar[XB_TMO], 1u); break; } }
  }
  nloc = mine > 0u ? mine : 1u; nx = cnt > 0u ? cnt : 1u;
}
DI void xcd_barrier(const XcdBarrier& b) {
  asm volatile("s_waitcnt vmcnt(0)" ::: "memory");
  __syncthreads();
  if (threadIdx.x == 0) {
    unsigned* bar = b.bar;
    __builtin_amdgcn_s_waitcnt(0);
    unsigned nloc = b.st[0], nx = b.st[1];
    if (nloc == 0u) { xcd_barrier_complete(bar, b.x, nloc, nx); b.st[0] = nloc; b.st[1] = nx; }
    const unsigned old = xb_add(&bar[XB_XSUB(b.x)], 1u);
    const unsigned gen = old / nloc;
    if (old + 1u == (gen + 1u) * nloc) {
      __builtin_amdgcn_fence(__ATOMIC_RELEASE, "agent");
      asm volatile("s_waitcnt vmcnt(0)" ::: "memory");
      const unsigned og = xb_add(&bar[XB_TOP], 1u);
      const unsigned tg = og / nx;
      if (og + 1u == (tg + 1u) * nx) xb_add(&bar[XB_TOPGEN], 1u);
      else XB_SPIN(xb_ld(&bar[XB_TOPGEN]) == tg, bar);
      __builtin_amdgcn_fence(__ATOMIC_ACQUIRE, "agent");
      xb_add(&bar[XB_XGEN(b.x)], 1u);
      asm volatile("s_waitcnt vmcnt(0)" ::: "memory");
    } else {
      XB_SPIN(xb_ld(&bar[XB_XGEN(b.x)]) == gen, bar);
      __builtin_amdgcn_fence(__ATOMIC_ACQUIRE, "agent");
      asm volatile("s_waitcnt vmcnt(0)" ::: "memory");
    }
  }
  __syncthreads();
}

constexpr int BM = 256, BK = 64, HALF = 128, HTB = HALF * BK * 2;
DI int lds_byte(int r, int c) { int st = (r >> 4) * 2 + (c >> 5), rr = r & 15, cc = c & 31, ob = rr * 64 + cc * 2; return st * 1024 + (ob ^ (((ob >> 9) & 1) << 5)); }
DI void stage_rc(int b, int& R, int& C) { int st = b / 1024, sb = b % 1024, swz = sb ^ (((sb >> 9) & 1) << 5); R = (st >> 1) * 16 + swz / 64; C = (st & 1) * 32 + (swz % 64) / 2; }
DI int perm32(int rho) { const int n = rho >> 4, i = rho & 15; return 8 * (i >> 2) + 4 * n + (i & 3); }
struct GUnit { const char* a; const char* b; int rowbase, colbase, mode; };

DI void st8(bf16_t* dst, const f32x4 a, const f32x4 b) {
  u32x4 w; w.x = pk_bf16(a[0], a[1]); w.y = pk_bf16(a[2], a[3]); w.z = pk_bf16(b[0], b[1]); w.w = pk_bf16(b[2], b[3]);
  *(u32x4*)dst = w;
}
DI void cv8(const u32x4 a, f32x4& lo, f32x4& hi) { lo = (f32x4){bflo(a.x), bfhi(a.x), bflo(a.y), bfhi(a.y)}; hi = (f32x4){bflo(a.z), bfhi(a.z), bflo(a.w), bfhi(a.w)}; }

template <int MS>
DI void epi_regs(const Params& P, const GUnit& u, f32x4 (&acc)[2][2][4][2], int wr, int wc, int fr, int fq) {
  const int mode = u.mode;
  const int rb = u.rowbase + 64 * wr + fr, cb = u.colbase + 64 * wc + 8 * fq;
  if ((MS & 1) && (mode == 0 || mode == 1 || mode == 5 || mode == 6 || mode == 4)) {
#pragma unroll
    for (int ai = 0; ai < 2; ++ai)
#pragma unroll
      for (int m = 0; m < 4; ++m)
#pragma unroll
        for (int bj = 0; bj < 2; ++bj) {
          const int row = rb + 128 * ai + 16 * m, col = cb + 32 * bj;
          f32x4 v0 = acc[ai][bj][m][0], v1 = acc[ai][bj][m][1];
          if (mode == 1 || mode == 5) {
#pragma unroll
            for (int j = 0; j < 4; ++j) { v0[j] = siluf_(v0[j]); v1[j] = siluf_(v1[j]); }
          }
          bf16_t* dst;
          if (mode == 0) dst = P.U + (size_t)row * 512 + col;
          else if (mode == 1) dst = P.Zs + (size_t)row * 512 + (col - 512);
          else if (mode == 5) dst = P.Za + (size_t)row * 512 + (col - 2560);
          else if (mode == 6) dst = P.PP + (size_t)row * 1024 + col;
          else dst = P.Vt + ((size_t)((col >> 12) * 512 + row)) * 4096 + (col & 4095);
          st8(dst, v0, v1);
        }
  } else if ((MS & 2) && (mode == 2 || mode == 3)) {
    const float* w = (mode == 2) ? P.qnw : P.knw;
    const f32x4 w00 = *(const f32x4*)(w + 8 * fq), w01 = *(const f32x4*)(w + 8 * fq + 4), w10 = *(const f32x4*)(w + 32 + 8 * fq), w11 = *(const f32x4*)(w + 32 + 8 * fq + 4);
    const float sgn = (fq == 0) ? -1.0f : 1.0f;
    const float osc = (mode == 2) ? (0.125f * LOG2E) : 1.0f;
#pragma unroll
    for (int ai = 0; ai < 2; ++ai)
#pragma unroll
      for (int m = 0; m < 4; ++m) {
        const int row = rb + 128 * ai + 16 * m;
        f32x4 a0 = acc[ai][0][m][0], a1 = acc[ai][0][m][1], b0 = acc[ai][1][m][0], b1 = acc[ai][1][m][1];
        float ss = 0.f;
#pragma unroll
        for (int j = 0; j < 4; ++j) ss += a0[j] * a0[j] + a1[j] * a1[j] + b0[j] * b0[j] + b1[j] * b1[j];
        ss += __shfl_xor(ss, 16); ss += __shfl_xor(ss, 32);
        const float rs = rsqrtf(ss * (1.0f / 64.0f) + 1e-6f);
        a0 = a0 * rs * w00; a1 = a1 * rs * w01; b0 = b0 * rs * w10; b1 = b1 * rs * w11;
        f32x4 p0, p1;
#pragma unroll
        for (int j = 0; j < 4; ++j) { p0[j] = __shfl_xor(a0[j], 16); p1[j] = __shfl_xor(a1[j], 16); }
        if (fq < 2) {
          const f32x4* rt = (const f32x4*)(P.rope + (size_t)row * 16);
          const f32x4 t0 = rt[0], t1 = rt[1], t2 = rt[2], t3 = rt[3];
          a0[0] = a0[0] * t0[0] + sgn * p0[0] * t0[1]; a0[1] = a0[1] * t0[2] + sgn * p0[1] * t0[3];
          a0[2] = a0[2] * t1[0] + sgn * p0[2] * t1[1]; a0[3] = a0[3] * t1[2] + sgn * p0[3] * t1[3];
          a1[0] = a1[0] * t2[0] + sgn * p1[0] * t2[1]; a1[1] = a1[1] * t2[2] + sgn * p1[1] * t2[3];
          a1[2] = a1[2] * t3[0] + sgn * p1[2] * t3[1]; a1[3] = a1[3] * t3[2] + sgn * p1[3] * t3[3];
        }
        a0 = a0 * osc; a1 = a1 * osc; b0 = b0 * osc; b1 = b1 * osc;
        bf16_t* dst = ((mode == 2) ? P.Qb : P.Kb) + (size_t)row * 512 + (cb - ((mode == 2) ? 1024 : 1536));
        st8(dst, a0, a1); st8(dst + 32, b0, b1);
      }
  } else if ((MS & 4) && mode == 7) {
#pragma unroll
    for (int ai = 0; ai < 2; ++ai) {
      u32x4 yg[4][2], zs[4][2];
#pragma unroll
      for (int m = 0; m < 4; ++m)
#pragma unroll
        for (int bj = 0; bj < 2; ++bj) { const size_t o = (size_t)(rb + 128 * ai + 16 * m) * 512 + cb + 32 * bj; yg[m][bj] = *(const u32x4*)(P.Yg + o); zs[m][bj] = *(const u32x4*)(P.Zs + o); }
#pragma unroll
      for (int m = 0; m < 4; ++m)
#pragma unroll
        for (int bj = 0; bj < 2; ++bj) {
          const int row = rb + 128 * ai + 16 * m, col = cb + 32 * bj;
          const f32x4 g0 = *(const f32x4*)(P.glu_b + col), g1 = *(const f32x4*)(P.glu_b + col + 4);
          f32x4 y0, y1, z0, z1; cv8(yg[m][bj], y0, y1); cv8(zs[m][bj], z0, z1);
          f32x4 v0 = acc[ai][bj][m][0], v1 = acc[ai][bj][m][1];
#pragma unroll
          for (int j = 0; j < 4; ++j) { v0[j] = y0[j] * sigmoidf_(v0[j] + g0[j]) * z0[j]; v1[j] = y1[j] * sigmoidf_(v1[j] + g1[j]) * z1[j]; }
          st8(P.Ycat + (size_t)row * 1024 + col, v0, v1);
        }
    }
  } else if ((MS & 8) && mode == 8) {
#pragma unroll
    for (int ai = 0; ai < 2; ++ai)
#pragma unroll
      for (int mh = 0; mh < 2; ++mh) {
        f32x4 xv[2][2][2];
#pragma unroll
        for (int mm = 0; mm < 2; ++mm)
#pragma unroll
          for (int bj = 0; bj < 2; ++bj) { const size_t o = (size_t)(rb + 128 * ai + 16 * (2 * mh + mm)) * 1024 + cb + 32 * bj; xv[mm][bj][0] = *(const f32x4*)(P.x + o); xv[mm][bj][1] = *(const f32x4*)(P.x + o + 4); }
#pragma unroll
        for (int mm = 0; mm < 2; ++mm)
#pragma unroll
          for (int bj = 0; bj < 2; ++bj) { const int m = 2 * mh + mm; const size_t o = (size_t)(rb + 128 * ai + 16 * m) * 1024 + cb + 32 * bj;
            st8(P.X1b + o, acc[ai][bj][m][0] + xv[mm][bj][0], acc[ai][bj][m][1] + xv[mm][bj][1]); }
      }
  } else if ((MS & 16) && mode == 9) {
#pragma unroll
    for (int ai = 0; ai < 2; ++ai) {
      u32x4 xb[4][2], pp[4][2];
#pragma unroll
      for (int m = 0; m < 4; ++m)
#pragma unroll
        for (int bj = 0; bj < 2; ++bj) { const size_t o = (size_t)(rb + 128 * ai + 16 * m) * 1024 + cb + 32 * bj; xb[m][bj] = *(const u32x4*)(P.X1b + o); pp[m][bj] = *(const u32x4*)(P.PP + o); }
#pragma unroll
      for (int m = 0; m < 4; ++m)
#pragma unroll
        for (int bj = 0; bj < 2; ++bj) {
          const size_t o = (size_t)(rb + 128 * ai + 16 * m) * 1024 + cb + 32 * bj;
          f32x4 x0, x1, q0, q1; cv8(xb[m][bj], x0, x1); cv8(pp[m][bj], q0, q1);
          const f32x4 v0 = acc[ai][bj][m][0], v1 = acc[ai][bj][m][1];
#pragma unroll
          for (int j = 0; j < 4; ++j) { x0[j] += sigmoidf_(v0[j]) * q0[j]; x1[j] += sigmoidf_(v1[j]) * q1[j]; }
          *(f32x4*)(P.out + o) = x0; *(f32x4*)(P.out + o + 4) = x1;
        }
    }
  }
}

template <int K, int MS, class Src>
__device__ __forceinline__ void gemm_stream(const Params& P, const Src& S) {
  extern __shared__ __attribute__((aligned(16))) unsigned char lds[];
  int tid = threadIdx.x; asm volatile("" : "+v"(tid));
  const int wid = __builtin_amdgcn_readfirstlane(tid >> 6), lane = tid & 63, wr = wid >> 2, wc = wid & 3, fr = lane & 15, fq = lane >> 4;
  constexpr int nt = K / BK;
  unsigned voffA[2], voffB[2];
#pragma unroll
  for (int i = 0; i < 2; ++i) { int R, C; stage_rc(tid * 16 + i * 8192, R, C); const int Rb = 64 * (R >> 5) + perm32(R & 31);
    voffA[i] = (unsigned)(R * K + C) * 2u; voffB[i] = (unsigned)(Rb * K + C) * 2u; }
  constexpr size_t kstep = (size_t)BK * 2, hstepA = (size_t)HALF * K * 2, hstepB = (size_t)32 * K * 2;
  const int aoff = lds_byte(wr * 64 + fr, fq * 8), boff = lds_byte(wc * 32 + fr, fq * 8);
#define GSA(b, h) (((b) * 2 + (h)) * HTB)
#define GSB(b, h) ((4 + (b) * 2 + (h)) * HTB)
#define GSTAGE(bufoff, gbase, voff) do { _Pragma("unroll") for (int _i = 0; _i < 2; ++_i) \
    __builtin_amdgcn_global_load_lds((const unsigned*)((const char*)(gbase) + (voff)[_i]), (LAS unsigned*)(lds + (bufoff) + tid * 16 + _i * 8192), 16, 0, 0); } while (0)
#define GLDA(dst, b, h) do { _Pragma("unroll") for (int m = 0; m < 4; ++m) _Pragma("unroll") for (int k = 0; k < 2; ++k) dst[m][k] = *(const bf16x8*)(lds + GSA(b, h) + aoff + m * 2048 + k * 1024); } while (0)
#define GLDB(dst, b, h) do { _Pragma("unroll") for (int n = 0; n < 2; ++n) _Pragma("unroll") for (int k = 0; k < 2; ++k) dst[n][k] = *(const bf16x8*)(lds + GSB(b, h) + boff + n * 2048 + k * 1024); } while (0)
#define GMMA(ai, bj, At_, Bt_) do { __builtin_amdgcn_s_setprio(1); _Pragma("unroll") for (int m = 0; m < 4; ++m) _Pragma("unroll") for (int n = 0; n < 2; ++n) _Pragma("unroll") for (int k = 0; k < 2; ++k) \
    acc[ai][bj][m][n] = __builtin_amdgcn_mfma_f32_16x16x32_bf16(Bt_[n][k], At_[m][k], acc[ai][bj][m][n], 0, 0, 0); __builtin_amdgcn_s_setprio(0); } while (0)
#define GWAIT_V(n) asm volatile("s_waitcnt vmcnt(" #n ")" ::: "memory")
#define GWAIT_L(n) asm volatile("s_waitcnt lgkmcnt(" #n ")" ::: "memory")
#define GBAR __builtin_amdgcn_s_barrier()
#define GSCHED __builtin_amdgcn_sched_barrier(0)
  GUnit cur, nxt; int ui = 0;
  if (!S.get(0, cur)) return;
  f32x4 acc[2][2][4][2];
#pragma unroll
  for (int a = 0; a < 2; ++a)
#pragma unroll
    for (int b = 0; b < 2; ++b)
#pragma unroll
      for (int m = 0; m < 4; ++m)
#pragma unroll
        for (int n = 0; n < 2; ++n) acc[a][b][m][n] = (f32x4){0.f, 0.f, 0.f, 0.f};
  bf16x8 At[4][2], B0[2][2], B1[2][2];
  const char* cA = cur.a; const char* cB = cur.b;
  __syncthreads();
#ifndef G_SP2
#define G_SP2 1
#endif
#if G_SP2
  GSTAGE(GSB(0, 0), cB, voffB); GSTAGE(GSB(0, 1), cB + hstepB, voffB); GSTAGE(GSA(0, 0), cA, voffA); GSTAGE(GSA(0, 1), cA + hstepA, voffA);
  if (wr == 1) GBAR;
  GWAIT_V(2); GBAR;
  GSTAGE(GSB(1, 0), cB + kstep, voffB); GSTAGE(GSA(1, 0), cA + kstep, voffA); GSTAGE(GSB(1, 1), cB + hstepB + kstep, voffB);
  GWAIT_V(6); GBAR;
#else
  GSTAGE(GSB(0, 0), cB, voffB); GSTAGE(GSA(0, 0), cA, voffA); GSTAGE(GSB(0, 1), cB + hstepB, voffB); GSTAGE(GSA(0, 1), cA + hstepA, voffA);
  if (wr == 1) GBAR;
  GWAIT_V(4); GBAR;
  GSTAGE(GSB(1, 0), cB + kstep, voffB); GSTAGE(GSA(1, 0), cA + kstep, voffA); GSTAGE(GSB(1, 1), cB + hstepB + kstep, voffB);
  GWAIT_V(6); GBAR;
#endif
  bool first_unit = true;
  for (;;) {
    const bool has_next = S.get(ui + 1, nxt);
    const char* nA = has_next ? nxt.a : cA; const char* nB = has_next ? nxt.b : cB;
#pragma unroll 1
    for (int t = 0; t < nt; t += 2) {
      const bool last = (t == nt - 2);
      const char* a1 = cA + (size_t)(t + 1) * kstep;
      const char* a2 = last ? nA : cA + (size_t)(t + 2) * kstep; const char* b2 = last ? nB : cB + (size_t)(t + 2) * kstep;
      const char* a3 = a2 + kstep; const char* b3 = b2 + kstep;
#if G_SP2
      const bool relaxed = (t == 0) && !first_unit;
#define GWV8R() do { if (relaxed) GWAIT_V(24); else GWAIT_V(8); } while (0)
      GLDB(B0, 0, 0); GLDB(B1, 0, 1); GSCHED; GLDA(At, 0, 0); if (!relaxed) GSTAGE(GSA(1, 1), a1 + hstepA, voffA);
      GWV8R(); GWAIT_L(0); GBAR; GMMA(0, 0, At, B0); GMMA(0, 1, At, B1); GBAR; GSCHED;
      GLDA(At, 0, 1); GSTAGE(GSB(0, 0), b2, voffB); GSTAGE(GSB(0, 1), b2 + hstepB, voffB); GSTAGE(GSA(0, 0), a2, voffA);
      GWV8R(); GWAIT_L(0); GBAR; GMMA(1, 0, At, B0); GMMA(1, 1, At, B1); GBAR; GSCHED;
      GLDB(B0, 1, 0); GLDB(B1, 1, 1); GSCHED; GLDA(At, 1, 0); GSTAGE(GSA(0, 1), a2 + hstepA, voffA);
      GWV8R(); GWAIT_L(0); GBAR; GMMA(0, 0, At, B0); GMMA(0, 1, At, B1); GBAR; GSCHED;
      GLDA(At, 1, 1); GSTAGE(GSB(1, 0), b3, voffB); GSTAGE(GSB(1, 1), b3 + hstepB, voffB); GSTAGE(GSA(1, 0), a3, voffA);
      GWAIT_V(8); GWAIT_L(0); GBAR; GMMA(1, 0, At, B0); GMMA(1, 1, At, B1); GBAR; GSCHED;
#else
      GLDB(B0, 0, 0); GSCHED; GLDA(At, 0, 0); GSTAGE(GSA(1, 1), a1 + hstepA, voffA);
      GWAIT_L(8); GBAR; GWAIT_L(0); GMMA(0, 0, At, B0); GBAR; GSCHED;
      GLDB(B1, 0, 1); GSTAGE(GSB(0, 0), b2, voffB);
      GBAR; GWAIT_L(0); GMMA(0, 1, At, B1); GBAR;
      GLDA(At, 0, 1); GSTAGE(GSA(0, 0), a2, voffA);
      GBAR; GWAIT_L(0); GMMA(1, 0, At, B0); GBAR; GSCHED;
      GSTAGE(GSB(0, 1), b2 + hstepB, voffB);
      GWAIT_V(6); GBAR; GMMA(1, 1, At, B1); GBAR;
      GLDB(B0, 1, 0); GSCHED; GLDA(At, 1, 0); GSTAGE(GSA(0, 1), a2 + hstepA, voffA);
      GWAIT_L(8); GBAR; GWAIT_L(0); GMMA(0, 0, At, B0); GBAR; GSCHED;
      GLDB(B1, 1, 1); GSTAGE(GSB(1, 0), b3, voffB);
      GBAR; GWAIT_L(0); GMMA(0, 1, At, B1); GBAR;
      GLDA(At, 1, 1); GSTAGE(GSA(1, 0), a3, voffA);
      GBAR; GWAIT_L(0); GMMA(1, 0, At, B0); GBAR; GSCHED;
      GSTAGE(GSB(1, 1), b3 + hstepB, voffB);
      GWAIT_V(6); GBAR; GMMA(1, 1, At, B1); GBAR;
#endif
    }
#ifndef G_ALIGN
#define G_ALIGN 1
#endif
    if (G_ALIGN) { if (wr == 0) GBAR; }
    if (has_next) GSTAGE(GSA(1, 1), nA + kstep + hstepA, voffA);
    epi_regs<MS>(P, cur, acc, wr, wc, fr, fq);
    if (!has_next) break;
#pragma unroll
    for (int a = 0; a < 2; ++a)
#pragma unroll
      for (int b = 0; b < 2; ++b)
#pragma unroll
        for (int m = 0; m < 4; ++m)
#pragma unroll
          for (int n = 0; n < 2; ++n) acc[a][b][m][n] = (f32x4){0.f, 0.f, 0.f, 0.f};
    cur = nxt; cA = nA; cB = nB; ++ui; first_unit = false;
    if (G_ALIGN) { if (wr == 1) GBAR; }
  }
  GWAIT_V(0);
  if (!G_ALIGN) { if (wr == 0) GBAR; }
  GBAR;
}

DI bool tile_order(int L, int nM, int nN, int& pm, int& pn) {
  const int nwg = nM * nN; if (L >= nwg) return false;
  int wgid = L; { const int q = nwg / 8, r = nwg % 8, xcd = wgid % 8, off = wgid / 8; wgid = (xcd < r ? xcd * (q + 1) : r * (q + 1) + (xcd - r) * q) + off; }
  const int nig = 8 * nN, gid = wgid / nig, fm = gid * 8, gsz = (nM - fm) < 8 ? (nM - fm) : 8;
  pm = fm + ((wgid % nig) % gsz); pn = (wgid % nig) / gsz; return true;
}

DI void transpose_w(const float* __restrict__ src, bf16_t* __restrict__ dst, int K, int N, int gtid, int gthreads) {
  const int total = (K / 8) * N;
  for (int idx = gtid; idx < total; idx += gthreads) {
    const int n = idx % N, k0 = (idx / N) * 8;
    float f[8];
#pragma unroll
    for (int j = 0; j < 8; ++j) f[j] = src[(size_t)(k0 + j) * N + n];
    u32x4 w; w.x = pk_bf16(f[0], f[1]); w.y = pk_bf16(f[2], f[3]); w.z = pk_bf16(f[4], f[5]); w.w = pk_bf16(f[6], f[7]);
    *(u32x4*)(dst + (size_t)n * K + k0) = w;
  }
}
__device__ void phase0(const Params& P, int bid, int nb) {
  const int tid = threadIdx.x, lane = tid & 63, wid = tid >> 6;
  const int gtid = bid * NTHR + tid, gthreads = nb * NTHR;
  transpose_w(P.w_in, P.WtIn, 1024, 3072, gtid, gthreads);
  transpose_w(P.glu_w, P.WtGlu, 512, 512, gtid, gthreads);
  transpose_w(P.w_out, P.WtOut, 1024, 1024, gtid, gthreads);
  transpose_w(P.wp, P.WtP, 256, 1024, gtid, gthreads);
  transpose_w(P.wg, P.WtG, 1024, 1024, gtid, gthreads);
  for (int idx = gtid; idx < NTOK * 8; idx += gthreads) {
    const int tok = idx >> 3, i = idx & 7;
    const float invf = exp2f(-(float)i * 0.125f * 18.931568569324174f);
    const float ang = (float)P.pos[tok] * invf;
    double t = (double)ang * 0.15915494309189535; t -= floor(t);
    const float tf = (float)t;
    P.rope[(size_t)idx * 2] = __builtin_amdgcn_cosf(tf); P.rope[(size_t)idx * 2 + 1] = __builtin_amdgcn_sinf(tf);
  }
  for (int idx0 = gtid; idx0 < NTOK * 256 / 8; idx0 += gthreads * 4) {
    f32x4 a[4], b[4];
#pragma unroll
    for (int u = 0; u < 4; ++u) { const int idx = idx0 + u * gthreads; if (idx < NTOK * 256 / 8) { a[u] = *(const f32x4*)(P.p + (size_t)idx * 8); b[u] = *(const f32x4*)(P.p + (size_t)idx * 8 + 4); } }
#pragma unroll
    for (int u = 0; u < 4; ++u) { const int idx = idx0 + u * gthreads; if (idx < NTOK * 256 / 8) {
      u32x4 w; w.x = pk_bf16(a[u][0], a[u][1]); w.y = pk_bf16(a[u][2], a[u][3]); w.z = pk_bf16(b[u][0], b[u][1]); w.w = pk_bf16(b[u][2], b[u][3]);
      *(u32x4*)(P.Pb + (size_t)idx * 8) = w; } }
  }
  for (int row = (bid * 8 + wid) * 4; row < NTOK; row += nb * 32) {
    f32x4 v[4][4]; float ss[4] = {0.f, 0.f, 0.f, 0.f};
#pragma unroll
    for (int rr = 0; rr < 4; ++rr)
#pragma unroll
      for (int i = 0; i < 4; ++i) v[rr][i] = *(const f32x4*)(P.x + (size_t)(row + rr) * 1024 + i * 256 + lane * 4);
#pragma unroll
    for (int rr = 0; rr < 4; ++rr)
#pragma unroll
      for (int i = 0; i < 4; ++i) ss[rr] += v[rr][i][0] * v[rr][i][0] + v[rr][i][1] * v[rr][i][1] + v[rr][i][2] * v[rr][i][2] + v[rr][i][3] * v[rr][i][3];
#pragma unroll
    for (int o = 1; o < 64; o <<= 1) {
#pragma unroll
      for (int rr = 0; rr < 4; ++rr) ss[rr] += __shfl_xor(ss[rr], o);
    }
#pragma unroll
    for (int rr = 0; rr < 4; ++rr) {
      const float rs = rsqrtf(ss[rr] * (1.0f / 1024.0f) + 1e-6f);
#pragma unroll
      for (int i = 0; i < 4; ++i) {
        const f32x4 w = *(const f32x4*)(P.norm_w + i * 256 + lane * 4);
        u32x2 o; o.x = pk_bf16(v[rr][i][0] * rs * w[0], v[rr][i][1] * rs * w[1]); o.y = pk_bf16(v[rr][i][2] * rs * w[2], v[rr][i][3] * rs * w[3]);
        *(u32x2*)(P.Hb + (size_t)(row + rr) * 1024 + i * 256 + lane * 4) = o;
      }
    }
  }
}

struct SrcIn { const Params* P; int bid, nb;
  DI bool get(int ui, GUnit& u) const {
    int pm, pn; if (!tile_order(ui * nb + bid, 128, 12, pm, pn)) return false;
    const bool isv = (pn == 8 || pn == 9);
    u.a = (const char*)(isv ? (P->WtIn + (size_t)(2048 + (pn - 8) * 256) * 1024) : (P->Hb + (size_t)pm * 256 * 1024));
    u.b = (const char*)(isv ? (P->Hb + (size_t)pm * 256 * 1024) : (P->WtIn + (size_t)pn * 256 * 1024));
    u.rowbase = isv ? (pn - 8) * 256 : pm * 256; u.colbase = isv ? pm * 256 : pn * 256;
    u.mode = (pn < 2) ? 0 : (pn < 4) ? 1 : (pn < 6) ? 2 : (pn < 8) ? 3 : isv ? 4 : 5; return true; } };
struct SrcPle { const Params* P; int bid, nb;
  DI bool get(int ui, GUnit& u) const {
    int pm, pn; if (!tile_order(ui * nb + bid, 128, 4, pm, pn)) return false;
    u.a = (const char*)(P->Pb + (size_t)pm * 256 * 256); u.b = (const char*)(P->WtP + (size_t)pn * 256 * 256); u.rowbase = pm * 256; u.colbase = pn * 256; u.mode = 6; return true; } };
struct SrcN1024 { const bf16_t* A; const bf16_t* B; int mode, bid, nb;
  DI bool get(int ui, GUnit& u) const {
    int pm, pn; if (!tile_order(ui * nb + bid, 128, 4, pm, pn)) return false;
    u.a = (const char*)(A + (size_t)pm * 256 * 1024); u.b = (const char*)(B + (size_t)pn * 256 * 1024); u.rowbase = pm * 256; u.colbase = pn * 256; u.mode = mode; return true; } };
struct SrcGlu { const Params* P; int bid, nb;
  DI bool get(int ui, GUnit& u) const {
    int pm, pn; if (!tile_order(ui * nb + bid, 128, 2, pm, pn)) return false;
    u.a = (const char*)(P->Yg + (size_t)pm * 256 * 512); u.b = (const char*)(P->WtGlu + (size_t)pn * 256 * 512); u.rowbase = pm * 256; u.colbase = pn * 256; u.mode = 7; return true; } };
__device__ void phase1(const Params& P, int bid, int nb) { SrcIn s{&P, bid, nb}; gemm_stream<1024, 3>(P, s); }

__device__ void phase_ssm_naive(const Params& P, int bid, int nb) {
  extern __shared__ __attribute__((aligned(16))) float smf[];
  float* cre = smf;
  float* cim = smf + 1024;
  float* xs = smf + 2048;
  float* us = smf + 4096;
  const int tid = threadIdx.x;
  for (int item = bid; item < 256; item += nb) {
    const int b = item >> 5, g = item & 31;
    __syncthreads();
    for (int i = tid; i < 1024; i += NTHR) { cre[i] = P.c_re[g * 1024 + i]; cim[i] = P.c_im[g * 1024 + i]; }
    float ar = 0.f, ai = 0.f, bbr[16], bbi[16], xr = 0.f, xi = 0.f;
    if (tid < 64) {
      const int n = tid;
      const float lr = P.lam_re[g * 64 + n], li = P.lam_im[g * 64 + n], dt = __expf(P.log_dt[g]);
      const float mag = __expf(lr * dt);
      double tt = (double)(li * dt) * 0.15915494309189535; tt -= floor(tt);
      ar = mag * __builtin_amdgcn_cosf((float)tt); ai = mag * __builtin_amdgcn_sinf((float)tt);
      const float nr = ar - 1.0f, ni = ai, den = lr * lr + li * li;
      const float cr = (nr * lr + ni * li) / den, ci = (ni * lr - nr * li) / den;
#pragma unroll
      for (int q = 0; q < 16; ++q) { const float br = P.b_re[(g * 64 + n) * 16 + q], bi = P.b_im[(g * 64 + n) * 16 + q]; bbr[q] = cr * br - ci * bi; bbi[q] = cr * bi + ci * br; }
    }
    for (int t0 = 0; t0 < SEQ; t0 += 16) {
      __syncthreads();
      if (tid < 256) us[tid] = bf2f(P.U[(size_t)(b * SEQ + t0 + (tid >> 4)) * 512 + g * 16 + (tid & 15)]);
      __syncthreads();
      if (tid < 64) {
#pragma unroll 1
        for (int tau = 0; tau < 16; ++tau) {
          float br = 0.f, bi = 0.f;
#pragma unroll
          for (int q = 0; q < 16; ++q) { const float u = us[tau * 16 + q]; br += bbr[q] * u; bi += bbi[q] * u; }
          const float nxr = ar * xr - ai * xi + br, nxi = ar * xi + ai * xr + bi; xr = nxr; xi = nxi;
          xs[(tau * 64 + tid) * 2] = xr; xs[(tau * 64 + tid) * 2 + 1] = xi;
        }
      }
      __syncthreads();
      if (tid < 256) {
        const int tau = tid >> 4, pch = tid & 15; float y = 0.f;
        for (int n = 0; n < 64; ++n) y += cre[pch * 64 + n] * xs[(tau * 64 + n) * 2] - cim[pch * 64 + n] * xs[(tau * 64 + n) * 2 + 1];
        y += P.ssm_d[g * 16 + pch] * us[tid];
        y = gelu_tanh(y);
        P.Yg[(size_t)(b * SEQ + t0 + tau) * 512 + g * 16 + pch] = (bf16_t)(pk_bf16(y, 0.f) & 0xffffu);
      }
    }
  }
  __syncthreads();
}

__device__ void phase_attn_naive(const Params& P, int bid, int nb) {
  extern __shared__ __attribute__((aligned(16))) float smf[];
  const int tid = threadIdx.x, lane = tid & 63, wid = tid >> 6;
  float* pl = smf + wid * 4224;
  float* qs = pl + 4096;
  float mq = 0.f, mk = 0.f, s1 = 0.f, s2 = 0.f;
  { const float a = fabsf(P.qnw[lane]), b = fabsf(P.knw[lane]); mq = a; mk = b; s1 = P.lq1[lane] * P.lk1[lane]; s2 = P.lq2[lane] * P.lk2[lane];
#pragma unroll
    for (int o = 1; o < 64; o <<= 1) { mq = fmaxf(mq, __shfl_xor(mq, o)); mk = fmaxf(mk, __shfl_xor(mk, o)); s1 += __shfl_xor(s1, o); s2 += __shfl_xor(s2, o); } }
  const float lam = __expf(s1) - __expf(s2) + 0.2f;
  const float mb = 8.0f * mq * mk * LOG2E;
  for (int item = bid * 8 + wid; item < 8 * 4 * SEQ; item += nb * 8) {
    const int i = item & 4095, h = (item >> 12) & 3, b = item >> 14;
    const size_t tok = (size_t)b * SEQ + i;
    float o[2][2], l[2];
#pragma unroll
    for (int c = 0; c < 2; ++c) {
      asm volatile("s_waitcnt lgkmcnt(0)" ::: "memory");
      qs[lane] = bf2f(P.Qb[tok * 512 + h * 128 + c * 64 + lane]);
      asm volatile("s_waitcnt lgkmcnt(0)" ::: "memory");
      float ls = 0.f;
      for (int k0 = 0; k0 <= i; k0 += 64) {
        const int key = k0 + lane; float pv = 0.f;
        if (key <= i) {
          const bf16_t* kr = P.Kb + ((size_t)b * SEQ + key) * 512 + h * 128 + c * 64; float s = 0.f;
#pragma unroll
          for (int d8 = 0; d8 < 8; ++d8) { const u32x4 kw = *(const u32x4*)(kr + d8 * 8); const f32x4 qa = *(const f32x4*)(qs + d8 * 8), qb = *(const f32x4*)(qs + d8 * 8 + 4);
            s += bflo(kw.x) * qa[0] + bfhi(kw.x) * qa[1] + bflo(kw.y) * qa[2] + bfhi(kw.y) * qa[3] + bflo(kw.z) * qb[0] + bfhi(kw.z) * qb[1] + bflo(kw.w) * qb[2] + bfhi(kw.w) * qb[3]; }
          pv = exp2f(s - mb);
        }
        pl[key] = pv; ls += pv;
      }
#pragma unroll
      for (int of = 1; of < 64; of <<= 1) ls += __shfl_xor(ls, of);
      l[c] = ls;
      asm volatile("s_waitcnt lgkmcnt(0)" ::: "memory");
      const int nk = ((i >> 6) + 1) * 64;
      float o0 = 0.f, o1 = 0.f;
      const bf16_t* v0 = P.Vt + ((size_t)(b * 512 + h * 128 + lane)) * 4096; const bf16_t* v1 = v0 + (size_t)64 * 4096;
      for (int k = 0; k < nk; k += 8) {
        const u32x4 a = *(const u32x4*)(v0 + k), bb = *(const u32x4*)(v1 + k); const f32x4 pa = *(const f32x4*)(pl + k), pb = *(const f32x4*)(pl + k + 4);
        o0 += bflo(a.x) * pa[0] + bfhi(a.x) * pa[1] + bflo(a.y) * pa[2] + bfhi(a.y) * pa[3] + bflo(a.z) * pb[0] + bfhi(a.z) * pb[1] + bflo(a.w) * pb[2] + bfhi(a.w) * pb[3];
        o1 += bflo(bb.x) * pa[0] + bfhi(bb.x) * pa[1] + bflo(bb.y) * pa[2] + bfhi(bb.y) * pa[3] + bflo(bb.z) * pb[0] + bfhi(bb.z) * pb[1] + bflo(bb.w) * pb[2] + bfhi(bb.w) * pb[3];
      }
      o[c][0] = o0; o[c][1] = o1;
    }
    const float r0 = o[0][0] / l[0] - lam * o[1][0] / l[1], r1 = o[0][1] / l[0] - lam * o[1][1] / l[1];
    float ss = r0 * r0 + r1 * r1;
#pragma unroll
    for (int of = 1; of < 64; of <<= 1) ss += __shfl_xor(ss, of);
    const float rs = rsqrtf(ss * (1.0f / 128.0f) + 1e-6f) * 0.8f;
    const float y0 = r0 * rs * P.subln_w[lane] * bf2f(P.Za[tok * 512 + h * 128 + lane]);
    const float y1 = r1 * rs * P.subln_w[lane + 64] * bf2f(P.Za[tok * 512 + h * 128 + 64 + lane]);
    P.Ycat[tok * 1024 + 512 + h * 128 + lane] = (bf16_t)(pk_bf16(y0, 0.f) & 0xffffu);
    P.Ycat[tok * 1024 + 512 + h * 128 + 64 + lane] = (bf16_t)(pk_bf16(y1, 0.f) & 0xffffu);
  }
  __syncthreads();
}

__device__ void phase_ssm(const Params& P, int bid, int nb) {
  extern __shared__ __attribute__((aligned(16))) unsigned char sm[];
  constexpr int XP = 288;
  int tid = threadIdx.x; asm volatile("" : "+v"(tid));
  const int lane = tid & 63, wid = __builtin_amdgcn_readfirstlane(tid >> 6), r = lane & 31, hl = lane >> 5;
  float* E = (float*)sm;
  unsigned char* xw = sm + 8192 + wid * (32 * XP);
  const int hs_r = (r >> 2) & 1, tau_r = (r & 3) + 4 * (r >> 3);
  const int pch = lane & 15, kq = lane >> 4;
  for (int item = bid; item < 256; item += nb) {
    const int b = item >> 5, g = item & 31;
    __syncthreads();
    float ar[2], ai[2], a256r[2], a256i[2];
    bf16x8 Bre[2], Bim[2], Cf[4];
    {
      const float dt = __expf(P.log_dt[g]);
#pragma unroll
      for (int sh = 0; sh < 2; ++sh) {
        const int n = r + 32 * sh;
        const float lr = P.lam_re[g * 64 + n], li = P.lam_im[g * 64 + n];
        const float mag = __expf(lr * dt);
        double tt = (double)(li * dt) * 0.15915494309189535; tt -= floor(tt);
        ar[sh] = mag * __builtin_amdgcn_cosf((float)tt); ai[sh] = mag * __builtin_amdgcn_sinf((float)tt);
        const float nr = ar[sh] - 1.0f, ni = ai[sh], den = lr * lr + li * li;
        const float cr = (nr * lr + ni * li) / den, ci = (ni * lr - nr * li) / den;
        const f32x4 br0 = *(const f32x4*)(P.b_re + (g * 64 + n) * 16 + 8 * hl), br1 = *(const f32x4*)(P.b_re + (g * 64 + n) * 16 + 8 * hl + 4);
        const f32x4 bi0 = *(const f32x4*)(P.b_im + (g * 64 + n) * 16 + 8 * hl), bi1 = *(const f32x4*)(P.b_im + (g * 64 + n) * 16 + 8 * hl + 4);
        u32x4 wr_, wi_;
        wr_.x = pk_bf16(cr * br0[0] - ci * bi0[0], cr * br0[1] - ci * bi0[1]); wr_.y = pk_bf16(cr * br0[2] - ci * bi0[2], cr * br0[3] - ci * bi0[3]);
        wr_.z = pk_bf16(cr * br1[0] - ci * bi1[0], cr * br1[1] - ci * bi1[1]); wr_.w = pk_bf16(cr * br1[2] - ci * bi1[2], cr * br1[3] - ci * bi1[3]);
        wi_.x = pk_bf16(cr * bi0[0] + ci * br0[0], cr * bi0[1] + ci * br0[1]); wi_.y = pk_bf16(cr * bi0[2] + ci * br0[2], cr * bi0[3] + ci * br0[3]);
        wi_.z = pk_bf16(cr * bi1[0] + ci * br1[0], cr * bi1[1] + ci * br1[1]); wi_.w = pk_bf16(cr * bi1[2] + ci * br1[2], cr * bi1[3] + ci * br1[3]);
        Bre[sh] = __builtin_bit_cast(bf16x8, wr_); Bim[sh] = __builtin_bit_cast(bf16x8, wi_);
        float pr = ar[sh], pi = ai[sh];
#pragma unroll
        for (int q = 0; q < 8; ++q) { const float t = pr * pr - pi * pi; pi = 2.0f * pr * pi; pr = t; }
        a256r[sh] = pr; a256i[sh] = pi;
      }
#pragma unroll
      for (int ks = 0; ks < 4; ++ks) {
        const int n0 = 16 * ks + 4 * kq;
        const f32x4 cre = *(const f32x4*)(P.c_re + (g * 16 + pch) * 64 + n0), cim = *(const f32x4*)(P.c_im + (g * 16 + pch) * 64 + n0);
        u32x4 w; w.x = pk_bf16(cre[0], -cim[0]); w.y = pk_bf16(cre[1], -cim[1]); w.z = pk_bf16(cre[2], -cim[2]); w.w = pk_bf16(cre[3], -cim[3]);
        Cf[ks] = __builtin_bit_cast(bf16x8, w);
      }
    }
    bf16x8 Df;
    { const float dsk = P.ssm_d[g * 16 + pch]; u32x4 w = {0u, 0u, 0u, 0u};
      if (kq < 2) { const int jj = pch - 8 * kq; const unsigned hv = pk_bf16(dsk, 0.f) & 0xffffu;
        if (jj >= 0 && jj < 8) { const unsigned val = (jj & 1) ? (hv << 16) : hv; if ((jj >> 1) == 0) w.x = val; else if ((jj >> 1) == 1) w.y = val; else if ((jj >> 1) == 2) w.z = val; else w.w = val; } }
      Df = __builtin_bit_cast(bf16x8, w); }
    const unsigned uaoff = (unsigned)((kq < 2) ? (256 + 16 * kq) : (16 * (kq - 2)));
    const char* ub = (const char*)(P.U + ((size_t)b * SEQ + 512 * wid) * 512 + g * 16);
    char* yb = (char*)(P.Yg + ((size_t)b * SEQ + 512 * wid) * 512 + g * 16);
    const unsigned aoff = (unsigned)(((256 * hs_r + tau_r) * 512 + 8 * hl) * 2);
    float xr[2] = {0.f, 0.f}, xi[2] = {0.f, 0.f};
    f32x16 z16;
#pragma unroll
    for (int i = 0; i < 16; ++i) z16[i] = 0.f;
    bf16x8 afr[16];
#pragma unroll
    for (int t = 0; t < 16; ++t) afr[t] = *(const bf16x8*)(ub + aoff + (unsigned)(t * 16 * 512 * 2));
#pragma unroll
    for (int t = 0; t < 16; ++t) {
#pragma unroll
      for (int sh = 0; sh < 2; ++sh) {
        const f32x16 bur = __builtin_amdgcn_mfma_f32_32x32x16_bf16(afr[t], Bre[sh], z16, 0, 0, 0);
        const f32x16 bui = __builtin_amdgcn_mfma_f32_32x32x16_bf16(afr[t], Bim[sh], z16, 0, 0, 0);
#pragma unroll
        for (int i = 0; i < 16; ++i) { const float nr = ar[sh] * xr[sh] - ai[sh] * xi[sh] + bur[i], ni = ar[sh] * xi[sh] + ai[sh] * xr[sh] + bui[i]; xr[sh] = nr; xi[sh] = ni; }
      }
    }
    const int cidx = 2 * wid + hl;
#pragma unroll
    for (int sh = 0; sh < 2; ++sh) { E[(cidx * 64 + r + 32 * sh) * 2] = xr[sh]; E[(cidx * 64 + r + 32 * sh) * 2 + 1] = xi[sh]; }
    __syncthreads();
#pragma unroll
    for (int sh = 0; sh < 2; ++sh) { xr[sh] = 0.f; xi[sh] = 0.f; }
#pragma unroll 1
    for (int c2 = 0; c2 < 15; ++c2) {
      if (c2 < cidx) {
#pragma unroll
        for (int sh = 0; sh < 2; ++sh) {
          const float er = E[(c2 * 64 + r + 32 * sh) * 2], ei = E[(c2 * 64 + r + 32 * sh) * 2 + 1];
          const float nr = a256r[sh] * xr[sh] - a256i[sh] * xi[sh] + er, ni = a256r[sh] * xi[sh] + a256i[sh] * xr[sh] + ei; xr[sh] = nr; xi[sh] = ni;
        }
      }
    }
    {
      const f32x4 z4 = {0.f, 0.f, 0.f, 0.f};
#pragma unroll
      for (int t = 0; t < 16; ++t) {
        *(bf16x8*)(xw + (hs_r * 16 + tau_r) * XP + 256 + 16 * hl) = afr[t];
#pragma unroll
        for (int sh = 0; sh < 2; ++sh) {
          const f32x16 bur = __builtin_amdgcn_mfma_f32_32x32x16_bf16(afr[t], Bre[sh], z16, 0, 0, 0);
          const f32x16 bui = __builtin_amdgcn_mfma_f32_32x32x16_bf16(afr[t], Bim[sh], z16, 0, 0, 0);
#pragma unroll
          for (int i = 0; i < 16; ++i) {
            const float nr = ar[sh] * xr[sh] - ai[sh] * xi[sh] + bur[i], ni = ar[sh] * xi[sh] + ai[sh] * xr[sh] + bui[i]; xr[sh] = nr; xi[sh] = ni;
            *(unsigned*)(xw + (hl * 16 + i) * XP + (r + 32 * sh) * 4) = pk_bf16(nr, ni);
          }
        }
        asm volatile("s_waitcnt lgkmcnt(0)" ::: "memory");
#pragma unroll
        for (int mt = 0; mt < 2; ++mt) {
          f32x4 acc = z4;
#pragma unroll
          for (int ks = 0; ks < 4; ++ks) {
            const bf16x8 xa = *(const bf16x8*)(xw + (mt * 16 + pch) * XP + (32 * ks + 8 * kq) * 2);
            acc = __builtin_amdgcn_mfma_f32_16x16x32_bf16(xa, Cf[ks], acc, 0, 0, 0);
          }
          { const bf16x8 ua = *(const bf16x8*)(xw + (mt * 16 + pch) * XP + uaoff);
            acc = __builtin_amdgcn_mfma_f32_16x16x32_bf16(ua, Df, acc, 0, 0, 0); }
#pragma unroll
          for (int i = 0; i < 4; ++i) {
            const float y = gelu_tanh(acc[i]);
            *(bf16_t*)(yb + (unsigned)(((256 * mt + 16 * t + 4 * kq + i) * 512 + pch) * 2)) = (bf16_t)(pk_bf16(y, 0.f) & 0xffffu);
          }
        }
        asm volatile("s_waitcnt lgkmcnt(0)" ::: "memory");
      }
    }
  }
  __syncthreads();
}

DI int pi_row(int r) { const int hh = (r >> 2) & 1, i = (r & 3) + 4 * (r >> 3); return 16 * (i >> 3) + 8 * hh + (i & 7); }
DI int crow16(int i, int hh) { return (i & 3) + 8 * (i >> 2) + 4 * hh; }
__device__ void phase_attn(const Params& P, int bid, int nb) {
  extern __shared__ __attribute__((aligned(16))) unsigned char sm[];
  constexpr int KP = 272, VP = 272, KBYTES = 128 * KP, VBYTES = 128 * VP, BUF = KBYTES + VBYTES, YOFF = BUF, YP = 272;
  int tid = threadIdx.x; asm volatile("" : "+v"(tid));
  const int lane = tid & 63, wid = __builtin_amdgcn_readfirstlane(tid >> 6), c = wid >> 2, qs = wid & 3, r = lane & 31, hl = lane >> 5;
  float mq, mk, s1, s2;
  { mq = fabsf(P.qnw[lane]); mk = fabsf(P.knw[lane]); s1 = P.lq1[lane] * P.lk1[lane]; s2 = P.lq2[lane] * P.lk2[lane];
#pragma unroll
    for (int o = 1; o < 64; o <<= 1) { mq = fmaxf(mq, __shfl_xor(mq, o)); mk = fmaxf(mk, __shfl_xor(mk, o)); s1 += __shfl_xor(s1, o); s2 += __shfl_xor(s2, o); } }
  const float lam = __expf(s1) - __expf(s2) + 0.2f;
  const float nmb = -8.0f * mq * mk * LOG2E;
  const int pir = pi_row(r);
  const int vb = (nb % 8 == 0) ? (bid % 8) * (nb / 8) + bid / 8 : bid;
  for (int pid = vb; pid < 512; pid += nb) {
    const int bh = pid >> 4, kk = pid & 15, b = bh >> 2, h = bh & 3;
#pragma unroll 1
    for (int half = 0; half < 2; ++half) {
      const int qb = half ? kk : 31 - kk, q0 = qb * 128, qw0 = q0 + 32 * qs;
      const size_t tok0 = (size_t)b * SEQ;
      bf16x8 qf[4];
#pragma unroll
      for (int ks = 0; ks < 4; ++ks) qf[ks] = *(const bf16x8*)((const char*)(P.Qb + (tok0 + qw0) * 512 + h * 128 + c * 64) + (unsigned)((r * 512 + ks * 16 + hl * 8) * 2));
      const bf16_t* kg = P.Kb + tok0 * 512 + h * 128;
      const bf16_t* vg = P.Vt + ((size_t)(b * 512 + h * 128)) * 4096;
      u32x4 st[8];
      int t3 = tid; asm volatile("" : "+v"(t3));
      const unsigned koff = (unsigned)((t3 >> 4) * 512 + (t3 & 15) * 8) * 2u, voff_ = (unsigned)((t3 >> 4) * 4096 + (t3 & 15) * 8) * 2u;
      const unsigned klds = (unsigned)((t3 >> 4) * KP + (t3 & 15) * 16), vlds = (unsigned)(KBYTES + (t3 >> 4) * VP + (t3 & 15) * 16);
      const int nst = qb + 1;
#pragma unroll
      for (int i = 0; i < 4; ++i) { st[i] = *(const u32x4*)((const char*)kg + koff + (unsigned)(i * 32 * 1024)); st[4 + i] = *(const u32x4*)((const char*)vg + voff_ + (unsigned)(i * 32 * 8192)); }
#pragma unroll
      for (int i = 0; i < 4; ++i) { *(u32x4*)(sm + klds + i * 32 * KP) = st[i]; *(u32x4*)(sm + vlds + i * 32 * VP) = st[4 + i]; }
      __syncthreads();
      f32x16 o[4];
#pragma unroll
      for (int dt = 0; dt < 4; ++dt)
#pragma unroll
        for (int i = 0; i < 16; ++i) o[dt][i] = 0.f;
      float l = 0.f;
#pragma unroll 1
      for (int stp = 0; stp < nst; ++stp) {
        const bool more = (stp + 1 < nst);
        if (more) {
#pragma unroll
          for (int i = 0; i < 4; ++i) { st[i] = *(const u32x4*)((const char*)kg + (size_t)(stp + 1) * (128 * 1024) + koff + (unsigned)(i * 32 * 1024)); st[4 + i] = *(const u32x4*)((const char*)vg + (size_t)(stp + 1) * 256 + voff_ + (unsigned)(i * 32 * 8192)); }
        }
        const unsigned char* bbuf = sm + (stp & 1) * BUF;
#pragma unroll
        for (int sub = 0; sub < 2; ++sub) {
        const int kt = 2 * stp + sub;
        if (64 * kt <= qw0 + 31) {
          const unsigned char* kbuf = bbuf + sub * 64 * KP; const unsigned char* vbuf = bbuf + KBYTES + sub * 128;
          f32x16 s[2];
#pragma unroll
          for (int i = 0; i < 16; ++i) { s[0][i] = nmb; s[1][i] = nmb; }
          __builtin_amdgcn_s_setprio(1);
#pragma unroll
          for (int ks = 0; ks < 4; ++ks) {
            const bf16x8 k0 = *(const bf16x8*)(kbuf + pir * KP + (c * 64 + ks * 16 + hl * 8) * 2);
            const bf16x8 k1 = *(const bf16x8*)(kbuf + (32 + pir) * KP + (c * 64 + ks * 16 + hl * 8) * 2);
            s[0] = __builtin_amdgcn_mfma_f32_32x32x16_bf16(k0, qf[ks], s[0], 0, 0, 0);
            s[1] = __builtin_amdgcn_mfma_f32_32x32x16_bf16(k1, qf[ks], s[1], 0, 0, 0);
          }
          __builtin_amdgcn_s_setprio(0);
          if (64 * kt + 63 > qw0) {
            asm volatile("" ::: "memory");
#pragma unroll
            for (int mt = 0; mt < 2; ++mt)
#pragma unroll
              for (int i = 0; i < 16; ++i) { const int key = 64 * kt + 32 * mt + 16 * (i >> 3) + 8 * hl + (i & 7); s[mt][i] = (key <= qw0 + r) ? s[mt][i] : -1.0e30f; }
            asm volatile("" ::: "memory");
          }
          bf16x8 pb[2][2];
#pragma unroll
          for (int mt = 0; mt < 2; ++mt) {
            float pv[16];
#pragma unroll
            for (int i = 0; i < 16; ++i) { const float e = __builtin_amdgcn_exp2f(s[mt][i]); pv[i] = e; l += e; }
#pragma unroll
            for (int sp = 0; sp < 2; ++sp) {
              u32x4 w; w.x = pk_bf16(pv[8 * sp], pv[8 * sp + 1]); w.y = pk_bf16(pv[8 * sp + 2], pv[8 * sp + 3]); w.z = pk_bf16(pv[8 * sp + 4], pv[8 * sp + 5]); w.w = pk_bf16(pv[8 * sp + 6], pv[8 * sp + 7]);
              pb[mt][sp] = __builtin_bit_cast(bf16x8, w);
            }
          }
          {
            bf16x8 vc[4], vn[4];
#pragma unroll
            for (int dt = 0; dt < 4; ++dt) vc[dt] = *(const bf16x8*)(vbuf + (32 * dt + r) * VP + (8 * hl) * 2);
#pragma unroll
            for (int g = 0; g < 4; ++g) {
              if (g < 3) {
#pragma unroll
                for (int dt = 0; dt < 4; ++dt) vn[dt] = *(const bf16x8*)(vbuf + (32 * dt + r) * VP + (16 * (g + 1) + 8 * hl) * 2);
              }
              __builtin_amdgcn_sched_barrier(0);
              __builtin_amdgcn_s_setprio(1);
#pragma unroll
              for (int dt = 0; dt < 4; ++dt) o[dt] = __builtin_amdgcn_mfma_f32_32x32x16_bf16(vc[dt], pb[g >> 1][g & 1], o[dt], 0, 0, 0);
              __builtin_amdgcn_s_setprio(0);
              __builtin_amdgcn_sched_barrier(0);
              if (g < 3) {
#pragma unroll
                for (int dt = 0; dt < 4; ++dt) vc[dt] = vn[dt];
              }
            }
          }
        }
        }
        if (more) {
          unsigned char* nb_ = sm + ((stp + 1) & 1) * BUF;
#pragma unroll
          for (int i = 0; i < 4; ++i) { *(u32x4*)(nb_ + klds + i * 32 * KP) = st[i]; *(u32x4*)(nb_ + vlds + i * 32 * VP) = st[4 + i]; }
        }
        __syncthreads();
      }
      l += __shfl_xor(l, 32);
      const float inv = 1.0f / l;
      float* oex = (float*)sm;
      if (c == 1) {
#pragma unroll
        for (int dt = 0; dt < 4; ++dt)
#pragma unroll
          for (int i = 0; i < 16; ++i) oex[(qs * 128 + 32 * dt + crow16(i, hl)) * 32 + r] = o[dt][i] * inv;
      }
      __syncthreads();
      if (c == 0) {
        float ss = 0.f;
#pragma unroll
        for (int dt = 0; dt < 4; ++dt)
#pragma unroll
          for (int i = 0; i < 16; ++i) { const float v = o[dt][i] * inv - lam * oex[(qs * 128 + 32 * dt + crow16(i, hl)) * 32 + r]; o[dt][i] = v; ss += v * v; }
        ss += __shfl_xor(ss, 32);
        const float rs = rsqrtf(ss * (1.0f / 128.0f) + 1e-6f) * 0.8f;
#pragma unroll
        for (int dt = 0; dt < 4; ++dt)
#pragma unroll
          for (int g = 0; g < 4; ++g) {
            const int dv0 = 32 * dt + 8 * g + 4 * hl;
            const f32x4 wv = *(const f32x4*)(P.subln_w + dv0);
            u32x2 w; w.x = pk_bf16(o[dt][4 * g] * rs * wv[0], o[dt][4 * g + 1] * rs * wv[1]); w.y = pk_bf16(o[dt][4 * g + 2] * rs * wv[2], o[dt][4 * g + 3] * rs * wv[3]);
            *(u32x2*)(sm + YOFF + (32 * qs + r) * YP + dv0 * 2) = w;
          }
      }
      __syncthreads();
      int t4 = tid; asm volatile("" : "+v"(t4));
      const char* zab = (const char*)(P.Za + (tok0 + q0) * 512 + h * 128);
      char* ycb = (char*)(P.Ycat + (tok0 + q0) * 1024 + 512 + h * 128);
#pragma unroll
      for (int i = 0; i < 4; ++i) {
        const int id = t4 + 512 * i, row = id >> 4, ch = id & 15;
        const u32x4 y8 = *(const u32x4*)(sm + YOFF + row * YP + ch * 16);
        const u32x4 za = *(const u32x4*)(zab + (unsigned)(row * 1024 + ch * 16));
        u32x4 w;
        w.x = pk_bf16(bflo(y8.x) * bflo(za.x), bfhi(y8.x) * bfhi(za.x)); w.y = pk_bf16(bflo(y8.y) * bflo(za.y), bfhi(y8.y) * bfhi(za.y));
        w.z = pk_bf16(bflo(y8.z) * bflo(za.z), bfhi(y8.z) * bfhi(za.z)); w.w = pk_bf16(bflo(y8.w) * bflo(za.w), bfhi(y8.w) * bfhi(za.w));
        *(u32x4*)(ycb + (unsigned)(row * 2048 + ch * 16)) = w;
      }
    }
  }
  __syncthreads();
}

__device__ void phase3(const Params& P, int bid, int nb) { SrcGlu s{&P, bid, nb}; gemm_stream<512, 4>(P, s); }
__device__ void phase4(const Params& P, int bid, int nb) {
  const bool ple_first = ((bid >> 3) & 1) != 0;
  SrcPle sp{&P, bid, nb}; SrcN1024 so{P.Ycat, P.WtOut, 8, bid, nb};
  if (ple_first) gemm_stream<256, 1>(P, sp);
  gemm_stream<1024, 8>(P, so);
  if (!ple_first) gemm_stream<256, 1>(P, sp);
}
__device__ void phase5(const Params& P, int bid, int nb) { SrcN1024 s{P.X1b, P.WtG, 9, bid, nb}; gemm_stream<1024, 16>(P, s); }

__global__ void __launch_bounds__(NTHR, 2) mega(Params P, int plo, int phi) {
  const int bid = blockIdx.x, nb = gridDim.x;
#define IN(k) (plo <= (k) && (k) < phi)
  extern __shared__ __attribute__((aligned(16))) unsigned char smk[];
  volatile LAS unsigned* xst = (volatile LAS unsigned*)(smk + LDS_BYTES);
  if (threadIdx.x < 4) xst[threadIdx.x] = 0u;
  __syncthreads();
  XcdBarrier xbar = xcd_barrier_post(P.barw, xst);
  if (plo > 1000) cg::this_grid().sync();
#define SEAM(k) do { if (IN(k) && IN((k) + 1)) xcd_barrier(xbar); } while (0)
#ifndef REP
#define REP -1
#endif
#define GS() xcd_barrier(xbar)
  if (IN(0)) { phase0(P, bid, nb); if (REP == 0) { GS(); phase0(P, bid, nb); } }
  SEAM(0);
  if (IN(1)) { phase1(P, bid, nb); if (REP == 1) { GS(); phase1(P, bid, nb); } }
  SEAM(1);
  if (IN(2)) { phase_ssm(P, bid, nb); if (REP == 2) { GS(); phase_ssm(P, bid, nb); } phase_attn(P, bid, nb); if (REP == 6) { GS(); phase_attn(P, bid, nb); } }
  SEAM(2);
  if (IN(3)) { phase3(P, bid, nb); if (REP == 3) { GS(); phase3(P, bid, nb); } }
  SEAM(3);
  if (IN(4)) { phase4(P, bid, nb); if (REP == 4) { GS(); phase4(P, bid, nb); } }
  SEAM(4);
  if (IN(5)) phase5(P, bid, nb);
  if (REP == 5) { GS(); phase4(P, bid, nb); GS(); phase5(P, bid, nb); }
}

#ifndef N_LAUNCH_MODE
#define N_LAUNCH_MODE 1
#endif

extern "C" void kernel_launch(void* const* d_in, const int* in_sizes, int n_in, void* d_out, int out_size, void* d_ws, size_t ws_size, hipStream_t stream) {
  Params P{};
  P.x = (const float*)d_in[0]; P.p = (const float*)d_in[1]; P.pos = (const int*)d_in[2];
  P.norm_w = (const float*)d_in[3]; P.w_in = (const float*)d_in[4]; P.lam_re = (const float*)d_in[5]; P.lam_im = (const float*)d_in[6];
  P.log_dt = (const float*)d_in[7]; P.b_re = (const float*)d_in[8]; P.b_im = (const float*)d_in[9]; P.c_re = (const float*)d_in[10]; P.c_im = (const float*)d_in[11];
  P.ssm_d = (const float*)d_in[12]; P.glu_w = (const float*)d_in[13]; P.glu_b = (const float*)d_in[14]; P.qnw = (const float*)d_in[15]; P.knw = (const float*)d_in[16];
  P.lq1 = (const float*)d_in[17]; P.lk1 = (const float*)d_in[18]; P.lq2 = (const float*)d_in[19]; P.lk2 = (const float*)d_in[20]; P.subln_w = (const float*)d_in[21];
  P.w_out = (const float*)d_in[22]; P.wp = (const float*)d_in[23]; P.wg = (const float*)d_in[24];
  P.out = (float*)d_out;
  char* w = (char*)d_ws; size_t off = 16384;
  P.barw = (unsigned*)d_ws;
  auto take = [&](size_t bytes) { char* r = w + off; off += (bytes + 255) & ~(size_t)255; return (bf16_t*)r; };
  P.Hb = take((size_t)NTOK * 1024 * 2); P.X1b = P.Hb;
  P.WtIn = take((size_t)3072 * 1024 * 2); P.WtGlu = take((size_t)512 * 512 * 2); P.WtOut = take((size_t)1024 * 1024 * 2);
  P.WtP = take((size_t)1024 * 256 * 2); P.WtG = take((size_t)1024 * 1024 * 2);
  P.Pb = take((size_t)NTOK * 256 * 2);
  P.U = take((size_t)NTOK * 512 * 2); P.Zs = take((size_t)NTOK * 512 * 2); P.Qb = take((size_t)NTOK * 512 * 2); P.Kb = take((size_t)NTOK * 512 * 2);
  P.Vt = take((size_t)NTOK * 512 * 2); P.Za = take((size_t)NTOK * 512 * 2); P.Yg = take((size_t)NTOK * 512 * 2);
  P.Ycat = take((size_t)NTOK * 1024 * 2); P.PP = take((size_t)NTOK * 1024 * 2);
  P.rope = (float*)take((size_t)NTOK * 16 * 4);

  static int grid_blocks = 0;
  if (!grid_blocks) {
    hipFuncSetAttribute((const void*)mega, hipFuncAttributeMaxDynamicSharedMemorySize, LDS_BYTES + 256);
    int dev = 0, cus = 0, per_cu = 0;
    hipGetDevice(&dev);
    hipDeviceGetAttribute(&cus, hipDeviceAttributeMultiprocessorCount, dev);
    hipOccupancyMaxActiveBlocksPerMultiprocessor(&per_cu, mega, NTHR, LDS_BYTES + 256);
    if (per_cu < 1) per_cu = 1;
    grid_blocks = cus;
  }
#if N_LAUNCH_MODE == 1
  hipMemsetAsync(d_ws, 0, 16384, stream);
  int plo = 0, phi = 6;
  void* args[] = {&P, &plo, &phi};
  hipError_t e = hipLaunchCooperativeKernel((void*)mega, dim3(grid_blocks), dim3(NTHR), args, LDS_BYTES + 256, stream);
  if (e != hipSuccess) fprintf(stderr, "cooperative launch failed: %s (grid %d)\n", hipGetErrorString(e), grid_blocks);
#else
  for (int ph = 0; ph < 6; ++ph) hipLaunchKernelGGL(mega, dim3(grid_blocks), dim3(NTHR), LDS_BYTES, stream, P, ph, ph + 1);
#endif
}
```

```cpp
#include <hip/hip_runtime.h>
#include <hip/hip_cooperative_groups.h>
#include <stdint.h>
#include <cstdio>
namespace cg = cooperative_groups;

typedef unsigned short bf16_t;
typedef short bf16x8 __attribute__((ext_vector_type(8)));
typedef float f32x4 __attribute__((ext_vector_type(4)));
typedef float f32x16 __attribute__((ext_vector_type(16)));
typedef unsigned u32x4 __attribute__((ext_vector_type(4)));
typedef unsigned u32x2 __attribute__((ext_vector_type(2)));

#define NTOK 32768
#define SEQ 4096
#define DM 1024
#define INC 3072
#define NTHR 512
#define LDS_BYTES 139264
#define LOG2E 1.4426950408889634f

struct Params {
  const float *x, *p; const int* pos;
  const float *norm_w, *w_in, *lam_re, *lam_im, *log_dt, *b_re, *b_im, *c_re, *c_im, *ssm_d, *glu_w, *glu_b,
      *qnw, *knw, *lq1, *lk1, *lq2, *lk2, *subln_w, *w_out, *wp, *wg;
  float* out;
  float* rope; unsigned* barw;
  bf16_t *Hb, *WtIn, *WtGlu, *WtOut, *WtP, *WtG, *Pb, *U, *Zs, *Qb, *Kb, *Vt, *Za, *Yg, *Ycat, *X1b, *PP;
};

#define DI __device__ __forceinline__
DI unsigned pk_bf16(float lo, float hi) { unsigned r; asm("v_cvt_pk_bf16_f32 %0, %1, %2" : "=v"(r) : "v"(lo), "v"(hi)); return r; }
DI float bflo(unsigned w) { return __uint_as_float(w << 16); }
DI float bfhi(unsigned w) { return __uint_as_float(w & 0xffff0000u); }
DI float bf2f(bf16_t v) { return __uint_as_float(((unsigned)v) << 16); }
DI float sigmoidf_(float v) { return __builtin_amdgcn_rcpf(1.0f + __builtin_amdgcn_exp2f(-LOG2E * v)); }
DI float siluf_(float v) { return v * __builtin_amdgcn_rcpf(1.0f + __builtin_amdgcn_exp2f(-LOG2E * v)); }
DI float gelu_tanh(float v) { float u = 0.7978845608028654f * (v + 0.044715f * v * v * v); return v * __builtin_amdgcn_rcpf(1.0f + __builtin_amdgcn_exp2f(-2.0f * LOG2E * u)); }
DI void store16bf(bf16_t* dst, const f32x4 (&v)[4]) {
  u32x4 a, b;
  a.x = pk_bf16(v[0][0], v[0][1]); a.y = pk_bf16(v[0][2], v[0][3]); a.z = pk_bf16(v[1][0], v[1][1]); a.w = pk_bf16(v[1][2], v[1][3]);
  b.x = pk_bf16(v[2][0], v[2][1]); b.y = pk_bf16(v[2][2], v[2][3]); b.z = pk_bf16(v[3][0], v[3][1]); b.w = pk_bf16(v[3][2], v[3][3]);
  *(u32x4*)dst = a; *(u32x4*)(dst + 8) = b;
}
DI void cvt16bf(const u32x4 a, const u32x4 b, f32x4 (&v)[4]) {
  v[0] = (f32x4){bflo(a.x), bfhi(a.x), bflo(a.y), bfhi(a.y)}; v[1] = (f32x4){bflo(a.z), bfhi(a.z), bflo(a.w), bfhi(a.w)};
  v[2] = (f32x4){bflo(b.x), bfhi(b.x), bflo(b.y), bfhi(b.y)}; v[3] = (f32x4){bflo(b.z), bfhi(b.z), bflo(b.w), bfhi(b.w)};
}
DI void load16bf(const bf16_t* src, f32x4 (&v)[4]) {
  u32x4 a = *(const u32x4*)src, b = *(const u32x4*)(src + 8);
  v[0] = (f32x4){bflo(a.x), bfhi(a.x), bflo(a.y), bfhi(a.y)}; v[1] = (f32x4){bflo(a.z), bfhi(a.z), bflo(a.w), bfhi(a.w)};
  v[2] = (f32x4){bflo(b.x), bfhi(b.x), bflo(b.y), bfhi(b.y)}; v[3] = (f32x4){bflo(b.z), bfhi(b.z), bflo(b.w), bfhi(b.w)};
}

#define XB_TMO      128
#define XB_XCNT(j)  (256  + 64 * (j))
#define XB_XSUB(j)  (1280 + 64 * (j))
#define XB_XGEN(j)  (2304 + 64 * (j))
#define XB_TOP      3328
#define XB_TOPGEN   3392
#define XCD_BAR_WORDS 3456
#define XB_SPIN_CAP (1u << 18)
#define LAS __attribute__((address_space(3)))
DI unsigned xb_ld(unsigned* p) { return __hip_atomic_load(p, __ATOMIC_RELAXED, __HIP_MEMORY_SCOPE_AGENT); }
DI unsigned xb_add(unsigned* p, unsigned v) { return __hip_atomic_fetch_add(p, v, __ATOMIC_RELAXED, __HIP_MEMORY_SCOPE_AGENT); }
DI unsigned xb_xcc_id() { return (unsigned)__builtin_amdgcn_s_getreg((3 << 11) | 20) & 0xFu; }
#define XB_SPIN(cond, bar) do { unsigned _sp = 0; while (cond) { __builtin_amdgcn_s_sleep(1); \
    if ((++_sp & 255u) == 0u) { if (xb_ld(&(bar)[XB_TMO])) break; if (_sp > XB_SPIN_CAP) { atomicAdd(&(bar)[XB_TMO], 1u); break; } } } } while (0)
struct XcdBarrier { unsigned* bar; unsigned x; volatile LAS unsigned* st; };
DI XcdBarrier xcd_barrier_post(unsigned* bar, volatile LAS unsigned* st) {
  XcdBarrier b; b.bar = bar; b.x = xb_xcc_id(); b.st = st;
  if (threadIdx.x == 0) (void)xb_add(&bar[XB_XCNT(b.x)], 1u);
  return b;
}
DI void xcd_barrier_complete(unsigned* bar, unsigned x, unsigned& nloc, unsigned& nx) {
  const unsigned G = gridDim.x * gridDim.y * gridDim.z;
  unsigned sum, cnt, mine, sp = 0u;
  for (;;) {
    sum = 0u; cnt = 0u; mine = 0u;
#pragma unroll
    for (unsigned j = 0; j < 16; ++j) { const unsigned c = xb_ld(&bar[XB_XCNT(j)]); sum += c; cnt += (c > 0u) ? 1u : 0u; mine = (j == x) ? c : mine; }
    if (sum == G) break;
    __builtin_amdgcn_s_sleep(1);
    if ((++sp & 255u) == 0u) { if (xb_ld(&bar[XB_TMO])) break; if (sp > XB_SPIN_CAP) { atomicAdd(&bar[XB_TMO], 1u); break; } }
  }
  nloc = mine > 0u ? mine : 1u; nx = cnt > 0u ? cnt : 1u;
}
DI void xcd_barrier(const XcdBarrier& b) {
  asm volatile("s_waitcnt vmcnt(0)" ::: "memory");
  __syncthreads();
  if (threadIdx.x == 0) {
    unsigned* bar = b.bar;
    __builtin_amdgcn_s_waitcnt(0);
    unsigned nloc = b.st[0], nx = b.st[1];
    if (nloc == 0u) { xcd_barrier_complete(bar, b.x, nloc, nx); b.st[0] = nloc; b.st[1] = nx; }
    const unsigned old = xb_add(&bar[XB_XSUB(b.x)], 1u);
    const unsigned gen = old / nloc;
    if (old + 1u == (gen + 1u) * nloc) {
      __builtin_amdgcn_fence(__ATOMIC_RELEASE, "agent");
      asm volatile("s_waitcnt vmcnt(0)" ::: "memory");
      const unsigned og = xb_add(&bar[XB_TOP], 1u);
      const unsigned tg = og / nx;
      if (og + 1u == (tg + 1u) * nx) xb_add(&bar[XB_TOPGEN], 1u);
      else XB_SPIN(xb_ld(&bar[XB_TOPGEN]) == tg, bar);
      __builtin_amdgcn_fence(__ATOMIC_ACQUIRE, "agent");
      xb_add(&bar[XB_XGEN(b.x)], 1u);
      asm volatile("s_waitcnt vmcnt(0)" ::: "memory");
    } else {
      XB_SPIN(xb_ld(&bar[XB_XGEN(b.x)]) == gen, bar);
      __builtin_amdgcn_fence(__ATOMIC_ACQUIRE, "agent");
      asm volatile("s_waitcnt vmcnt(0)" ::: "memory");
    }
  }
  __syncthreads();
}

constexpr int BM = 256, BK = 64, HALF = 128, HTB = HALF * BK * 2;
DI int lds_byte(int r, int c) { int st = (r >> 4) * 2 + (c >> 5), rr = r & 15, cc = c & 31, ob = rr * 64 + cc * 2; return st * 1024 + (ob ^ (((ob >> 9) & 1) << 5)); }
DI void stage_rc(int b, int& R, int& C) { int st = b / 1024, sb = b % 1024, swz = sb ^ (((sb >> 9) & 1) << 5); R = (st >> 1) * 16 + swz / 64; C = (st & 1) * 32 + (swz % 64) / 2; }
DI int perm32(int rho) { const int n = rho >> 4, i = rho & 15; return 8 * (i >> 2) + 4 * n + (i & 3); }
struct GUnit { const char* a; const char* b; int rowbase, colbase, mode; };

DI void st8(bf16_t* dst, const f32x4 a, const f32x4 b) {
  u32x4 w; w.x = pk_bf16(a[0], a[1]); w.y = pk_bf16(a[2], a[3]); w.z = pk_bf16(b[0], b[1]); w.w = pk_bf16(b[2], b[3]);
  *(u32x4*)dst = w;
}
DI void cv8(const u32x4 a, f32x4& lo, f32x4& hi) { lo = (f32x4){bflo(a.x), bfhi(a.x), bflo(a.y), bfhi(a.y)}; hi = (f32x4){bflo(a.z), bfhi(a.z), bflo(a.w), bfhi(a.w)}; }

template <int MS>
DI void epi_regs(const Params& P, const GUnit& u, f32x4 (&acc)[2][2][4][2], int wr, int wc, int fr, int fq) {
  const int mode = u.mode;
  const int rb = u.rowbase + 64 * wr + fr, cb = u.colbase + 64 * wc + 8 * fq;
  if ((MS & 1) && (mode == 0 || mode == 1 || mode == 5 || mode == 6 || mode == 4)) {
#pragma unroll
    for (int ai = 0; ai < 2; ++ai)
#pragma unroll
      for (int m = 0; m < 4; ++m)
#pragma unroll
        for (int bj = 0; bj < 2; ++bj) {
          const int row = rb + 128 * ai + 16 * m, col = cb + 32 * bj;
          f32x4 v0 = acc[ai][bj][m][0], v1 = acc[ai][bj][m][1];
          if (mode == 1 || mode == 5) {
#pragma unroll
            for (int j = 0; j < 4; ++j) { v0[j] = siluf_(v0[j]); v1[j] = siluf_(v1[j]); }
          }
          bf16_t* dst;
          if (mode == 0) dst = P.U + (size_t)row * 512 + col;
          else if (mode == 1) dst = P.Zs + (size_t)row * 512 + (col - 512);
          else if (mode == 5) dst = P.Za + (size_t)row * 512 + (col - 2560);
          else if (mode == 6) dst = P.PP + (size_t)row * 1024 + col;
          else dst = P.Vt + ((size_t)((col >> 12) * 512 + row)) * 4096 + (col & 4095);
          st8(dst, v0, v1);
        }
  } else if ((MS & 2) && (mode == 2 || mode == 3)) {
    const float* w = (mode == 2) ? P.qnw : P.knw;
    const f32x4 w00 = *(const f32x4*)(w + 8 * fq), w01 = *(const f32x4*)(w + 8 * fq + 4), w10 = *(const f32x4*)(w + 32 + 8 * fq), w11 = *(const f32x4*)(w + 32 + 8 * fq + 4);
    const float sgn = (fq == 0) ? -1.0f : 1.0f;
    const float osc = (mode == 2) ? (0.125f * LOG2E) : 1.0f;
#pragma unroll
    for (int ai = 0; ai < 2; ++ai)
#pragma unroll
      for (int m = 0; m < 4; ++m) {
        const int row = rb + 128 * ai + 16 * m;
        f32x4 a0 = acc[ai][0][m][0], a1 = acc[ai][0][m][1], b0 = acc[ai][1][m][0], b1 = acc[ai][1][m][1];
        float ss = 0.f;
#pragma unroll
        for (int j = 0; j < 4; ++j) ss += a0[j] * a0[j] + a1[j] * a1[j] + b0[j] * b0[j] + b1[j] * b1[j];
        ss += __shfl_xor(ss, 16); ss += __shfl_xor(ss, 32);
        const float rs = rsqrtf(ss * (1.0f / 64.0f) + 1e-6f);
        a0 = a0 * rs * w00; a1 = a1 * rs * w01; b0 = b0 * rs * w10; b1 = b1 * rs * w11;
        f32x4 p0, p1;
#pragma unroll
        for (int j = 0; j < 4; ++j) { p0[j] = __shfl_xor(a0[j], 16); p1[j] = __shfl_xor(a1[j], 16); }
        if (fq < 2) {
          const f32x4* rt = (const f32x4*)(P.rope + (size_t)row * 16);
          const f32x4 t0 = rt[0], t1 = rt[1], t2 = rt[2], t3 = rt[3];
          a0[0] = a0[0] * t0[0] + sgn * p0[0] * t0[1]; a0[1] = a0[1] * t0[2] + sgn * p0[1] * t0[3];
          a0[2] = a0[2] * t1[0] + sgn * p0[2] * t1[1]; a0[3] = a0[3] * t1[2] + sgn * p0[3] * t1[3];
          a1[0] = a1[0] * t2[0] + sgn * p1[0] * t2[1]; a1[1] = a1[1] * t2[2] + sgn * p1[1] * t2[3];
          a1[2] = a1[2] * t3[0] + sgn * p1[2] * t3[1]; a1[3] = a1[3] * t3[2] + sgn * p1[3] * t3[3];
        }
        a0 = a0 * osc; a1 = a1 * osc; b0 = b0 * osc; b1 = b1 * osc;
        bf16_t* dst = ((mode == 2) ? P.Qb : P.Kb) + (size_t)row * 512 + (cb - ((mode == 2) ? 1024 : 1536));
        st8(dst, a0, a1); st8(dst + 32, b0, b1);
      }
  } else if ((MS & 4) && mode == 7) {
#pragma unroll
    for (int ai = 0; ai < 2; ++ai) {
      u32x4 yg[4][2], zs[4][2];
#pragma unroll
      for (int m = 0; m < 4; ++m)
#pragma unroll
        for (int bj = 0; bj < 2; ++bj) { const size_t o = (size_t)(rb + 128 * ai + 16 * m) * 512 + cb + 32 * bj; yg[m][bj] = *(const u32x4*)(P.Yg + o); zs[m][bj] = *(const u32x4*)(P.Zs + o); }
#pragma unroll
      for (int m = 0; m < 4; ++m)
#pragma unroll
        for (int bj = 0; bj < 2; ++bj) {
          const int row = rb + 128 * ai + 16 * m, col = cb + 32 * bj;
          const f32x4 g0 = *(const f32x4*)(P.glu_b + col), g1 = *(const f32x4*)(P.glu_b + col + 4);
          f32x4 y0, y1, z0, z1; cv8(yg[m][bj], y0, y1); cv8(zs[m][bj], z0, z1);
          f32x4 v0 = acc[ai][bj][m][0], v1 = acc[ai][bj][m][1];
#pragma unroll
          for (int j = 0; j < 4; ++j) { v0[j] = y0[j] * sigmoidf_(v0[j] + g0[j]) * z0[j]; v1[j] = y1[j] * sigmoidf_(v1[j] + g1[j]) * z1[j]; }
          st8(P.Ycat + (size_t)row * 1024 + col, v0, v1);
        }
    }
  } else if ((MS & 8) && mode == 8) {
#pragma unroll
    for (int ai = 0; ai < 2; ++ai)
#pragma unroll
      for (int mh = 0; mh < 2; ++mh) {
        f32x4 xv[2][2][2];
#pragma unroll
        for (int mm = 0; mm < 2; ++mm)
#pragma unroll
          for (int bj = 0; bj < 2; ++bj) { const size_t o = (size_t)(rb + 128 * ai + 16 * (2 * mh + mm)) * 1024 + cb + 32 * bj; xv[mm][bj][0] = *(const f32x4*)(P.x + o); xv[mm][bj][1] = *(const f32x4*)(P.x + o + 4); }
#pragma unroll
        for (int mm = 0; mm < 2; ++mm)
#pragma unroll
          for (int bj = 0; bj < 2; ++bj) { const int m = 2 * mh + mm; const size_t o = (size_t)(rb + 128 * ai + 16 * m) * 1024 + cb + 32 * bj;
            st8(P.X1b + o, acc[ai][bj][m][0] + xv[mm][bj][0], acc[ai][bj][m][1] + xv[mm][bj][1]); }
      }
  } else if ((MS & 16) && mode == 9) {
#pragma unroll
    for (int ai = 0; ai < 2; ++ai) {
      u32x4 xb[4][2], pp[4][2];
#pragma unroll
      for (int m = 0; m < 4; ++m)
#pragma unroll
        for (int bj = 0; bj < 2; ++bj) { const size_t o = (size_t)(rb + 128 * ai + 16 * m) * 1024 + cb + 32 * bj; xb[m][bj] = *(const u32x4*)(P.X1b + o); pp[m][bj] = *(const u32x4*)(P.PP + o); }
#pragma unroll
      for (int m = 0; m < 4; ++m)
#pragma unroll
        for (int bj = 0; bj < 2; ++bj) {
          const size_t o = (size_t)(rb + 128 * ai + 16 * m) * 1024 + cb + 32 * bj;
          f32x4 x0, x1, q0, q1; cv8(xb[m][bj], x0, x1); cv8(pp[m][bj], q0, q1);
          const f32x4 v0 = acc[ai][bj][m][0], v1 = acc[ai][bj][m][1];
#pragma unroll
          for (int j = 0; j < 4; ++j) { x0[j] += sigmoidf_(v0[j]) * q0[j]; x1[j] += sigmoidf_(v1[j]) * q1[j]; }
          *(f32x4*)(P.out + o) = x0; *(f32x4*)(P.out + o + 4) = x1;
        }
    }
  }
}

template <int K, int MS, class Src>
__device__ __forceinline__ void gemm_stream(const Params& P, const Src& S) {
  extern __shared__ __attribute__((aligned(16))) unsigned char lds[];
  int tid = threadIdx.x; asm volatile("" : "+v"(tid));
  const int wid = __builtin_amdgcn_readfirstlane(tid >> 6), lane = tid & 63, wr = wid >> 2, wc = wid & 3, fr = lane & 15, fq = lane >> 4;
  constexpr int nt = K / BK;
  unsigned voffA[2], voffB[2];
#pragma unroll
  for (int i = 0; i < 2; ++i) { int R, C; stage_rc(tid * 16 + i * 8192, R, C); const int Rb = 64 * (R >> 5) + perm32(R & 31);
    voffA[i] = (unsigned)(R * K + C) * 2u; voffB[i] = (unsigned)(Rb * K + C) * 2u; }
  constexpr size_t kstep = (size_t)BK * 2, hstepA = (size_t)HALF * K * 2, hstepB = (size_t)32 * K * 2;
  const int aoff = lds_byte(wr * 64 + fr, fq * 8), boff = lds_byte(wc * 32 + fr, fq * 8);
#define GSA(b, h) (((b) * 2 + (h)) * HTB)
#define GSB(b, h) ((4 + (b) * 2 + (h)) * HTB)
#define GSTAGE(bufoff, gbase, voff) do { _Pragma("unroll") for (int _i = 0; _i < 2; ++_i) \
    __builtin_amdgcn_global_load_lds((const unsigned*)((const char*)(gbase) + (voff)[_i]), (LAS unsigned*)(lds + (bufoff) + tid * 16 + _i * 8192), 16, 0, 0); } while (0)
#define GLDA(dst, b, h) do { _Pragma("unroll") for (int m = 0; m < 4; ++m) _Pragma("unroll") for (int k = 0; k < 2; ++k) dst[m][k] = *(const bf16x8*)(lds + GSA(b, h) + aoff + m * 2048 + k * 1024); } while (0)
#define GLDB(dst, b, h) do { _Pragma("unroll") for (int n = 0; n < 2; ++n) _Pragma("unroll") for (int k = 0; k < 2; ++k) dst[n][k] = *(const bf16x8*)(lds + GSB(b, h) + boff + n * 2048 + k * 1024); } while (0)
#define GMMA(ai, bj, At_, Bt_) do { __builtin_amdgcn_s_setprio(1); _Pragma("unroll") for (int m = 0; m < 4; ++m) _Pragma("unroll") for (int n = 0; n < 2; ++n) _Pragma("unroll") for (int k = 0; k < 2; ++k) \
    acc[ai][bj][m][n] = __builtin_amdgcn_mfma_f32_16x16x32_bf16(Bt_[n][k], At_[m][k], acc[ai][bj][m][n], 0, 0, 0); __builtin_amdgcn_s_setprio(0); } while (0)
#define GWAIT_V(n) asm volatile("s_waitcnt vmcnt(" #n ")" ::: "memory")
#define GWAIT_L(n) asm volatile("s_waitcnt lgkmcnt(" #n ")" ::: "memory")
#define GBAR __builtin_amdgcn_s_barrier()
#define GSCHED __builtin_amdgcn_sched_barrier(0)
  GUnit cur, nxt; int ui = 0;
  if (!S.get(0, cur)) return;
  f32x4 acc[2][2][4][2];
#pragma unroll
  for (int a = 0; a < 2; ++a)
#pragma unroll
    for (int b = 0; b < 2; ++b)
#pragma unroll
      for (int m = 0; m < 4; ++m)
#pragma unroll
        for (int n = 0; n < 2; ++n) acc[a][b][m][n] = (f32x4){0.f, 0.f, 0.f, 0.f};
  bf16x8 At[4][2], B0[2][2], B1[2][2];
  const char* cA = cur.a; const char* cB = cur.b;
  __syncthreads();
#ifndef G_SP2
#define G_SP2 1
#endif
#if G_SP2
  GSTAGE(GSB(0, 0), cB, voffB); GSTAGE(GSB(0, 1), cB + hstepB, voffB); GSTAGE(GSA(0, 0), cA, voffA); GSTAGE(GSA(0, 1), cA + hstepA, voffA);
  if (wr == 1) GBAR;
  GWAIT_V(2); GBAR;
  GSTAGE(GSB(1, 0), cB + kstep, voffB); GSTAGE(GSA(1, 0), cA + kstep, voffA); GSTAGE(GSB(1, 1), cB + hstepB + kstep, voffB);
  GWAIT_V(6); GBAR;
#else
  GSTAGE(GSB(0, 0), cB, voffB); GSTAGE(GSA(0, 0), cA, voffA); GSTAGE(GSB(0, 1), cB + hstepB, voffB); GSTAGE(GSA(0, 1), cA + hstepA, voffA);
  if (wr == 1) GBAR;
  GWAIT_V(4); GBAR;
  GSTAGE(GSB(1, 0), cB + kstep, voffB); GSTAGE(GSA(1, 0), cA + kstep, voffA); GSTAGE(GSB(1, 1), cB + hstepB + kstep, voffB);
  GWAIT_V(6); GBAR;
#endif
  for (;;) {
    const bool has_next = S.get(ui + 1, nxt);
    const char* nA = has_next ? nxt.a : cA; const char* nB = has_next ? nxt.b : cB;
#pragma unroll 1
    for (int t = 0; t < nt; t += 2) {
      const bool last = (t == nt - 2);
      const char* a1 = cA + (size_t)(t + 1) * kstep;
      const char* a2 = last ? nA : cA + (size_t)(t + 2) * kstep; const char* b2 = last ? nB : cB + (size_t)(t + 2) * kstep;
      const char* a3 = a2 + kstep; const char* b3 = b2 + kstep;
#if G_SP2
      GLDB(B0, 0, 0); GLDB(B1, 0, 1); GSCHED; GLDA(At, 0, 0); GSTAGE(GSA(1, 1), a1 + hstepA, voffA);
      GWAIT_V(8); GWAIT_L(0); GBAR; GMMA(0, 0, At, B0); GMMA(0, 1, At, B1); GBAR; GSCHED;
      GLDA(At, 0, 1); GSTAGE(GSB(0, 0), b2, voffB); GSTAGE(GSB(0, 1), b2 + hstepB, voffB); GSTAGE(GSA(0, 0), a2, voffA);
      GWAIT_V(8); GWAIT_L(0); GBAR; GMMA(1, 0, At, B0); GMMA(1, 1, At, B1); GBAR; GSCHED;
      GLDB(B0, 1, 0); GLDB(B1, 1, 1); GSCHED; GLDA(At, 1, 0); GSTAGE(GSA(0, 1), a2 + hstepA, voffA);
      GWAIT_V(8); GWAIT_L(0); GBAR; GMMA(0, 0, At, B0); GMMA(0, 1, At, B1); GBAR; GSCHED;
      GLDA(At, 1, 1); GSTAGE(GSB(1, 0), b3, voffB); GSTAGE(GSB(1, 1), b3 + hstepB, voffB); GSTAGE(GSA(1, 0), a3, voffA);
      GWAIT_V(8); GWAIT_L(0); GBAR; GMMA(1, 0, At, B0); GMMA(1, 1, At, B1); GBAR; GSCHED;
#else
      GLDB(B0, 0, 0); GSCHED; GLDA(At, 0, 0); GSTAGE(GSA(1, 1), a1 + hstepA, voffA);
      GWAIT_L(8); GBAR; GWAIT_L(0); GMMA(0, 0, At, B0); GBAR; GSCHED;
      GLDB(B1, 0, 1); GSTAGE(GSB(0, 0), b2, voffB);
      GBAR; GWAIT_L(0); GMMA(0, 1, At, B1); GBAR;
      GLDA(At, 0, 1); GSTAGE(GSA(0, 0), a2, voffA);
      GBAR; GWAIT_L(0); GMMA(1, 0, At, B0); GBAR; GSCHED;
      GSTAGE(GSB(0, 1), b2 + hstepB, voffB);
      GWAIT_V(6); GBAR; GMMA(1, 1, At, B1); GBAR;
      GLDB(B0, 1, 0); GSCHED; GLDA(At, 1, 0); GSTAGE(GSA(0, 1), a2 + hstepA, voffA);
      GWAIT_L(8); GBAR; GWAIT_L(0); GMMA(0, 0, At, B0); GBAR; GSCHED;
      GLDB(B1, 1, 1); GSTAGE(GSB(1, 0), b3, voffB);
      GBAR; GWAIT_L(0); GMMA(0, 1, At, B1); GBAR;
      GLDA(At, 1, 1); GSTAGE(GSA(1, 0), a3, voffA);
      GBAR; GWAIT_L(0); GMMA(1, 0, At, B0); GBAR; GSCHED;
      GSTAGE(GSB(1, 1), b3 + hstepB, voffB);
      GWAIT_V(6); GBAR; GMMA(1, 1, At, B1); GBAR;
#endif
    }
#ifndef G_ALIGN
#define G_ALIGN 1
#endif
    if (G_ALIGN) { if (wr == 0) GBAR; }
    epi_regs<MS>(P, cur, acc, wr, wc, fr, fq);
    if (!has_next) break;
#pragma unroll
    for (int a = 0; a < 2; ++a)
#pragma unroll
      for (int b = 0; b < 2; ++b)
#pragma unroll
        for (int m = 0; m < 4; ++m)
#pragma unroll
          for (int n = 0; n < 2; ++n) acc[a][b][m][n] = (f32x4){0.f, 0.f, 0.f, 0.f};
    cur = nxt; cA = nA; cB = nB; ++ui;
    if (G_ALIGN) { if (wr == 1) GBAR; }
  }
  GWAIT_V(0);
  if (!G_ALIGN) { if (wr == 0) GBAR; }
  GBAR;
}

DI bool tile_order(int L, int nM, int nN, int& pm, int& pn) {
  const int nwg = nM * nN; if (L >= nwg) return false;
  int wgid = L; { const int q = nwg / 8, r = nwg % 8, xcd = wgid % 8, off = wgid / 8; wgid = (xcd < r ? xcd * (q + 1) : r * (q + 1) + (xcd - r) * q) + off; }
  const int nig = 8 * nN, gid = wgid / nig, fm = gid * 8, gsz = (nM - fm) < 8 ? (nM - fm) : 8;
  pm = fm + ((wgid % nig) % gsz); pn = (wgid % nig) / gsz; return true;
}

DI void transpose_w(const float* __restrict__ src, bf16_t* __restrict__ dst, int K, int N, int gtid, int gthreads) {
  const int total = (K / 8) * N;
  for (int idx = gtid; idx < total; idx += gthreads) {
    const int n = idx % N, k0 = (idx / N) * 8;
    float f[8];
#pragma unroll
    for (int j = 0; j < 8; ++j) f[j] = src[(size_t)(k0 + j) * N + n];
    u32x4 w; w.x = pk_bf16(f[0], f[1]); w.y = pk_bf16(f[2], f[3]); w.z = pk_bf16(f[4], f[5]); w.w = pk_bf16(f[6], f[7]);
    *(u32x4*)(dst + (size_t)n * K + k0) = w;
  }
}
__device__ void phase0(const Params& P, int bid, int nb) {
  const int tid = threadIdx.x, lane = tid & 63, wid = tid >> 6;
  const int gtid = bid * NTHR + tid, gthreads = nb * NTHR;
  transpose_w(P.w_in, P.WtIn, 1024, 3072, gtid, gthreads);
  transpose_w(P.glu_w, P.WtGlu, 512, 512, gtid, gthreads);
  transpose_w(P.w_out, P.WtOut, 1024, 1024, gtid, gthreads);
  transpose_w(P.wp, P.WtP, 256, 1024, gtid, gthreads);
  transpose_w(P.wg, P.WtG, 1024, 1024, gtid, gthreads);
  for (int idx = gtid; idx < NTOK * 8; idx += gthreads) {
    const int tok = idx >> 3, i = idx & 7;
    const float invf = exp2f(-(float)i * 0.125f * 18.931568569324174f);
    const float ang = (float)P.pos[tok] * invf;
    double t = (double)ang * 0.15915494309189535; t -= floor(t);
    const float tf = (float)t;
    P.rope[(size_t)idx * 2] = __builtin_amdgcn_cosf(tf); P.rope[(size_t)idx * 2 + 1] = __builtin_amdgcn_sinf(tf);
  }
  for (int idx0 = gtid; idx0 < NTOK * 256 / 8; idx0 += gthreads * 4) {
    f32x4 a[4], b[4];
#pragma unroll
    for (int u = 0; u < 4; ++u) { const int idx = idx0 + u * gthreads; if (idx < NTOK * 256 / 8) { a[u] = *(const f32x4*)(P.p + (size_t)idx * 8); b[u] = *(const f32x4*)(P.p + (size_t)idx * 8 + 4); } }
#pragma unroll
    for (int u = 0; u < 4; ++u) { const int idx = idx0 + u * gthreads; if (idx < NTOK * 256 / 8) {
      u32x4 w; w.x = pk_bf16(a[u][0], a[u][1]); w.y = pk_bf16(a[u][2], a[u][3]); w.z = pk_bf16(b[u][0], b[u][1]); w.w = pk_bf16(b[u][2], b[u][3]);
      *(u32x4*)(P.Pb + (size_t)idx * 8) = w; } }
  }
  for (int row = (bid * 8 + wid) * 4; row < NTOK; row += nb * 32) {
    f32x4 v[4][4]; float ss[4] = {0.f, 0.f, 0.f, 0.f};
#pragma unroll
    for (int rr = 0; rr < 4; ++rr)
#pragma unroll
      for (int i = 0; i < 4; ++i) v[rr][i] = *(const f32x4*)(P.x + (size_t)(row + rr) * 1024 + i * 256 + lane * 4);
#pragma unroll
    for (int rr = 0; rr < 4; ++rr)
#pragma unroll
      for (int i = 0; i < 4; ++i) ss[rr] += v[rr][i][0] * v[rr][i][0] + v[rr][i][1] * v[rr][i][1] + v[rr][i][2] * v[rr][i][2] + v[rr][i][3] * v[rr][i][3];
#pragma unroll
    for (int o = 1; o < 64; o <<= 1) {
#pragma unroll
      for (int rr = 0; rr < 4; ++rr) ss[rr] += __shfl_xor(ss[rr], o);
    }
#pragma unroll
    for (int rr = 0; rr < 4; ++rr) {
      const float rs = rsqrtf(ss[rr] * (1.0f / 1024.0f) + 1e-6f);
#pragma unroll
      for (int i = 0; i < 4; ++i) {
        const f32x4 w = *(const f32x4*)(P.norm_w + i * 256 + lane * 4);
        u32x2 o; o.x = pk_bf16(v[rr][i][0] * rs * w[0], v[rr][i][1] * rs * w[1]); o.y = pk_bf16(v[rr][i][2] * rs * w[2], v[rr][i][3] * rs * w[3]);
        *(u32x2*)(P.Hb + (size_t)(row + rr) * 1024 + i * 256 + lane * 4) = o;
      }
    }
  }
}

struct SrcIn { const Params* P; int bid, nb;
  DI bool get(int ui, GUnit& u) const {
    int pm, pn; if (!tile_order(ui * nb + bid, 128, 12, pm, pn)) return false;
    const bool isv = (pn == 8 || pn == 9);
    u.a = (const char*)(isv ? (P->WtIn + (size_t)(2048 + (pn - 8) * 256) * 1024) : (P->Hb + (size_t)pm * 256 * 1024));
    u.b = (const char*)(isv ? (P->Hb + (size_t)pm * 256 * 1024) : (P->WtIn + (size_t)pn * 256 * 1024));
    u.rowbase = isv ? (pn - 8) * 256 : pm * 256; u.colbase = isv ? pm * 256 : pn * 256;
    u.mode = (pn < 2) ? 0 : (pn < 4) ? 1 : (pn < 6) ? 2 : (pn < 8) ? 3 : isv ? 4 : 5; return true; } };
struct SrcPle { const Params* P; int bid, nb;
  DI bool get(int ui, GUnit& u) const {
    int pm, pn; if (!tile_order(ui * nb + bid, 128, 4, pm, pn)) return false;
    u.a = (const char*)(P->Pb + (size_t)pm * 256 * 256); u.b = (const char*)(P->WtP + (size_t)pn * 256 * 256); u.rowbase = pm * 256; u.colbase = pn * 256; u.mode = 6; return true; } };
struct SrcN1024 { const bf16_t* A; const bf16_t* B; int mode, bid, nb;
  DI bool get(int ui, GUnit& u) const {
    int pm, pn; if (!tile_order(ui * nb + bid, 128, 4, pm, pn)) return false;
    u.a = (const char*)(A + (size_t)pm * 256 * 1024); u.b = (const char*)(B + (size_t)pn * 256 * 1024); u.rowbase = pm * 256; u.colbase = pn * 256; u.mode = mode; return true; } };
struct SrcGlu { const Params* P; int bid, nb;
  DI bool get(int ui, GUnit& u) const {
    int pm, pn; if (!tile_order(ui * nb + bid, 128, 2, pm, pn)) return false;
    u.a = (const char*)(P->Yg + (size_t)pm * 256 * 512); u.b = (const char*)(P->WtGlu + (size_t)pn * 256 * 512); u.rowbase = pm * 256; u.colbase = pn * 256; u.mode = 7; return true; } };
__device__ void phase1(const Params& P, int bid, int nb) { SrcIn s{&P, bid, nb}; gemm_stream<1024, 3>(P, s); }

__device__ void phase_ssm_naive(const Params& P, int bid, int nb) {
  extern __shared__ __attribute__((aligned(16))) float smf[];
  float* cre = smf;
  float* cim = smf + 1024;
  float* xs = smf + 2048;
  float* us = smf + 4096;
  const int tid = threadIdx.x;
  for (int item = bid; item < 256; item += nb) {
    const int b = item >> 5, g = item & 31;
    __syncthreads();
    for (int i = tid; i < 1024; i += NTHR) { cre[i] = P.c_re[g * 1024 + i]; cim[i] = P.c_im[g * 1024 + i]; }
    float ar = 0.f, ai = 0.f, bbr[16], bbi[16], xr = 0.f, xi = 0.f;
    if (tid < 64) {
      const int n = tid;
      const float lr = P.lam_re[g * 64 + n], li = P.lam_im[g * 64 + n], dt = __expf(P.log_dt[g]);
      const float mag = __expf(lr * dt);
      double tt = (double)(li * dt) * 0.15915494309189535; tt -= floor(tt);
      ar = mag * __builtin_amdgcn_cosf((float)tt); ai = mag * __builtin_amdgcn_sinf((float)tt);
      const float nr = ar - 1.0f, ni = ai, den = lr * lr + li * li;
      const float cr = (nr * lr + ni * li) / den, ci = (ni * lr - nr * li) / den;
#pragma unroll
      for (int q = 0; q < 16; ++q) { const float br = P.b_re[(g * 64 + n) * 16 + q], bi = P.b_im[(g * 64 + n) * 16 + q]; bbr[q] = cr * br - ci * bi; bbi[q] = cr * bi + ci * br; }
    }
    for (int t0 = 0; t0 < SEQ; t0 += 16) {
      __syncthreads();
      if (tid < 256) us[tid] = bf2f(P.U[(size_t)(b * SEQ + t0 + (tid >> 4)) * 512 + g * 16 + (tid & 15)]);
      __syncthreads();
      if (tid < 64) {
#pragma unroll 1
        for (int tau = 0; tau < 16; ++tau) {
          float br = 0.f, bi = 0.f;
#pragma unroll
          for (int q = 0; q < 16; ++q) { const float u = us[tau * 16 + q]; br += bbr[q] * u; bi += bbi[q] * u; }
          const float nxr = ar * xr - ai * xi + br, nxi = ar * xi + ai * xr + bi; xr = nxr; xi = nxi;
          xs[(tau * 64 + tid) * 2] = xr; xs[(tau * 64 + tid) * 2 + 1] = xi;
        }
      }
      __syncthreads();
      if (tid < 256) {
        const int tau = tid >> 4, pch = tid & 15; float y = 0.f;
        for (int n = 0; n < 64; ++n) y += cre[pch * 64 + n] * xs[(tau * 64 + n) * 2] - cim[pch * 64 + n] * xs[(tau * 64 + n) * 2 + 1];
        y += P.ssm_d[g * 16 + pch] * us[tid];
        y = gelu_tanh(y);
        P.Yg[(size_t)(b * SEQ + t0 + tau) * 512 + g * 16 + pch] = (bf16_t)(pk_bf16(y, 0.f) & 0xffffu);
      }
    }
  }
  __syncthreads();
}

__device__ void phase_attn_naive(const Params& P, int bid, int nb) {
  extern __shared__ __attribute__((aligned(16))) float smf[];
  const int tid = threadIdx.x, lane = tid & 63, wid = tid >> 6;
  float* pl = smf + wid * 4224;
  float* qs = pl + 4096;
  float mq = 0.f, mk = 0.f, s1 = 0.f, s2 = 0.f;
  { const float a = fabsf(P.qnw[lane]), b = fabsf(P.knw[lane]); mq = a; mk = b; s1 = P.lq1[lane] * P.lk1[lane]; s2 = P.lq2[lane] * P.lk2[lane];
#pragma unroll
    for (int o = 1; o < 64; o <<= 1) { mq = fmaxf(mq, __shfl_xor(mq, o)); mk = fmaxf(mk, __shfl_xor(mk, o)); s1 += __shfl_xor(s1, o); s2 += __shfl_xor(s2, o); } }
  const float lam = __expf(s1) - __expf(s2) + 0.2f;
  const float mb = 8.0f * mq * mk * LOG2E;
  for (int item = bid * 8 + wid; item < 8 * 4 * SEQ; item += nb * 8) {
    const int i = item & 4095, h = (item >> 12) & 3, b = item >> 14;
    const size_t tok = (size_t)b * SEQ + i;
    float o[2][2], l[2];
#pragma unroll
    for (int c = 0; c < 2; ++c) {
      asm volatile("s_waitcnt lgkmcnt(0)" ::: "memory");
      qs[lane] = bf2f(P.Qb[tok * 512 + h * 128 + c * 64 + lane]);
      asm volatile("s_waitcnt lgkmcnt(0)" ::: "memory");
      float ls = 0.f;
      for (int k0 = 0; k0 <= i; k0 += 64) {
        const int key = k0 + lane; float pv = 0.f;
        if (key <= i) {
          const bf16_t* kr = P.Kb + ((size_t)b * SEQ + key) * 512 + h * 128 + c * 64; float s = 0.f;
#pragma unroll
          for (int d8 = 0; d8 < 8; ++d8) { const u32x4 kw = *(const u32x4*)(kr + d8 * 8); const f32x4 qa = *(const f32x4*)(qs + d8 * 8), qb = *(const f32x4*)(qs + d8 * 8 + 4);
            s += bflo(kw.x) * qa[0] + bfhi(kw.x) * qa[1] + bflo(kw.y) * qa[2] + bfhi(kw.y) * qa[3] + bflo(kw.z) * qb[0] + bfhi(kw.z) * qb[1] + bflo(kw.w) * qb[2] + bfhi(kw.w) * qb[3]; }
          pv = exp2f(s - mb);
        }
        pl[key] = pv; ls += pv;
      }
#pragma unroll
      for (int of = 1; of < 64; of <<= 1) ls += __shfl_xor(ls, of);
      l[c] = ls;
      asm volatile("s_waitcnt lgkmcnt(0)" ::: "memory");
      const int nk = ((i >> 6) + 1) * 64;
      float o0 = 0.f, o1 = 0.f;
      const bf16_t* v0 = P.Vt + ((size_t)(b * 512 + h * 128 + lane)) * 4096; const bf16_t* v1 = v0 + (size_t)64 * 4096;
      for (int k = 0; k < nk; k += 8) {
        const u32x4 a = *(const u32x4*)(v0 + k), bb = *(const u32x4*)(v1 + k); const f32x4 pa = *(const f32x4*)(pl + k), pb = *(const f32x4*)(pl + k + 4);
        o0 += bflo(a.x) * pa[0] + bfhi(a.x) * pa[1] + bflo(a.y) * pa[2] + bfhi(a.y) * pa[3] + bflo(a.z) * pb[0] + bfhi(a.z) * pb[1] + bflo(a.w) * pb[2] + bfhi(a.w) * pb[3];
        o1 += bflo(bb.x) * pa[0] + bfhi(bb.x) * pa[1] + bflo(bb.y) * pa[2] + bfhi(bb.y) * pa[3] + bflo(bb.z) * pb[0] + bfhi(bb.z) * pb[1] + bflo(bb.w) * pb[2] + bfhi(bb.w) * pb[3];
      }
      o[c][0] = o0; o[c][1] = o1;
    }
    const float r0 = o[0][0] / l[0] - lam * o[1][0] / l[1], r1 = o[0][1] / l[0] - lam * o[1][1] / l[1];
    float ss = r0 * r0 + r1 * r1;
#pragma unroll
    for (int of = 1; of < 64; of <<= 1) ss += __shfl_xor(ss, of);
    const float rs = rsqrtf(ss * (1.0f / 128.0f) + 1e-6f) * 0.8f;
    const float y0 = r0 * rs * P.subln_w[lane] * bf2f(P.Za[tok * 512 + h * 128 + lane]);
    const float y1 = r1 * rs * P.subln_w[lane + 64] * bf2f(P.Za[tok * 512 + h * 128 + 64 + lane]);
    P.Ycat[tok * 1024 + 512 + h * 128 + lane] = (bf16_t)(pk_bf16(y0, 0.f) & 0xffffu);
    P.Ycat[tok * 1024 + 512 + h * 128 + 64 + lane] = (bf16_t)(pk_bf16(y1, 0.f) & 0xffffu);
  }
  __syncthreads();
}

__device__ void phase_ssm(const Params& P, int bid, int nb) {
  extern __shared__ __attribute__((aligned(16))) unsigned char sm[];
  constexpr int XP = 288;
  int tid = threadIdx.x; asm volatile("" : "+v"(tid));
  const int lane = tid & 63, wid = __builtin_amdgcn_readfirstlane(tid >> 6), r = lane & 31, hl = lane >> 5;
  float* E = (float*)sm;
  unsigned char* xw = sm + 16384 + wid * (32 * XP);
  const int hs_r = (r >> 2) & 1, tau_r = (r & 3) + 4 * (r >> 3);
  const int pch = lane & 15, kq = lane >> 4;
  for (int item = bid; item < 256; item += nb) {
    const int b = item >> 5, g = item & 31;
    __syncthreads();
    float ar[2], ai[2], a256r[2], a256i[2];
    bf16x8 Bre[2], Bim[2], Cf[4];
    {
      const float dt = __expf(P.log_dt[g]);
#pragma unroll
      for (int sh = 0; sh < 2; ++sh) {
        const int n = r + 32 * sh;
        const float lr = P.lam_re[g * 64 + n], li = P.lam_im[g * 64 + n];
        const float mag = __expf(lr * dt);
        double tt = (double)(li * dt) * 0.15915494309189535; tt -= floor(tt);
        ar[sh] = mag * __builtin_amdgcn_cosf((float)tt); ai[sh] = mag * __builtin_amdgcn_sinf((float)tt);
        const float nr = ar[sh] - 1.0f, ni = ai[sh], den = lr * lr + li * li;
        const float cr = (nr * lr + ni * li) / den, ci = (ni * lr - nr * li) / den;
        const f32x4 br0 = *(const f32x4*)(P.b_re + (g * 64 + n) * 16 + 8 * hl), br1 = *(const f32x4*)(P.b_re + (g * 64 + n) * 16 + 8 * hl + 4);
        const f32x4 bi0 = *(const f32x4*)(P.b_im + (g * 64 + n) * 16 + 8 * hl), bi1 = *(const f32x4*)(P.b_im + (g * 64 + n) * 16 + 8 * hl + 4);
        u32x4 wr_, wi_;
        wr_.x = pk_bf16(cr * br0[0] - ci * bi0[0], cr * br0[1] - ci * bi0[1]); wr_.y = pk_bf16(cr * br0[2] - ci * bi0[2], cr * br0[3] - ci * bi0[3]);
        wr_.z = pk_bf16(cr * br1[0] - ci * bi1[0], cr * br1[1] - ci * bi1[1]); wr_.w = pk_bf16(cr * br1[2] - ci * bi1[2], cr * br1[3] - ci * bi1[3]);
        wi_.x = pk_bf16(cr * bi0[0] + ci * br0[0], cr * bi0[1] + ci * br0[1]); wi_.y = pk_bf16(cr * bi0[2] + ci * br0[2], cr * bi0[3] + ci * br0[3]);
        wi_.z = pk_bf16(cr * bi1[0] + ci * br1[0], cr * bi1[1] + ci * br1[1]); wi_.w = pk_bf16(cr * bi1[2] + ci * br1[2], cr * bi1[3] + ci * br1[3]);
        Bre[sh] = __builtin_bit_cast(bf16x8, wr_); Bim[sh] = __builtin_bit_cast(bf16x8, wi_);
        float pr = ar[sh], pi = ai[sh];
#pragma unroll
        for (int q = 0; q < 7; ++q) { const float t = pr * pr - pi * pi; pi = 2.0f * pr * pi; pr = t; }
        a256r[sh] = pr; a256i[sh] = pi;
      }
#pragma unroll
      for (int ks = 0; ks < 4; ++ks) {
        const int n0 = 16 * ks + 4 * kq;
        const f32x4 cre = *(const f32x4*)(P.c_re + (g * 16 + pch) * 64 + n0), cim = *(const f32x4*)(P.c_im + (g * 16 + pch) * 64 + n0);
        u32x4 w; w.x = pk_bf16(cre[0], -cim[0]); w.y = pk_bf16(cre[1], -cim[1]); w.z = pk_bf16(cre[2], -cim[2]); w.w = pk_bf16(cre[3], -cim[3]);
        Cf[ks] = __builtin_bit_cast(bf16x8, w);
      }
    }
    bf16x8 Df;
    { const float dsk = P.ssm_d[g * 16 + pch]; u32x4 w = {0u, 0u, 0u, 0u};
      if (kq < 2) { const int jj = pch - 8 * kq; const unsigned hv = pk_bf16(dsk, 0.f) & 0xffffu;
        if (jj >= 0 && jj < 8) { const unsigned val = (jj & 1) ? (hv << 16) : hv; if ((jj >> 1) == 0) w.x = val; else if ((jj >> 1) == 1) w.y = val; else if ((jj >> 1) == 2) w.z = val; else w.w = val; } }
      Df = __builtin_bit_cast(bf16x8, w); }
    const unsigned uaoff = (unsigned)((kq < 2) ? (256 + 16 * kq) : (16 * (kq - 2)));
    const char* ub = (const char*)(P.U + ((size_t)b * SEQ + 512 * wid) * 512 + g * 16);
    char* yb = (char*)(P.Yg + ((size_t)b * SEQ + 512 * wid) * 512 + g * 16);
    const unsigned aoff = (unsigned)(((128 * (2 * hs_r + (tau_r & 1)) + (tau_r >> 1)) * 512 + 8 * hl) * 2);
    typedef float f32x2v __attribute__((ext_vector_type(2)));
    f32x2v xr[2] = {{0.f, 0.f}, {0.f, 0.f}}, xi[2] = {{0.f, 0.f}, {0.f, 0.f}};
    f32x16 z16;
#pragma unroll
    for (int i = 0; i < 16; ++i) z16[i] = 0.f;
    bf16x8 afr[16];
#pragma unroll
    for (int t = 0; t < 16; ++t) afr[t] = *(const bf16x8*)(ub + aoff + (unsigned)(t * 8 * 512 * 2));
#pragma unroll
    for (int t = 0; t < 16; ++t) {
#pragma unroll
      for (int sh = 0; sh < 2; ++sh) {
        const f32x16 bur = __builtin_amdgcn_mfma_f32_32x32x16_bf16(afr[t], Bre[sh], z16, 0, 0, 0);
        const f32x16 bui = __builtin_amdgcn_mfma_f32_32x32x16_bf16(afr[t], Bim[sh], z16, 0, 0, 0);
#pragma unroll
        for (int j = 0; j < 8; ++j) { const f32x2v br2 = {bur[2 * j], bur[2 * j + 1]}, bi2 = {bui[2 * j], bui[2 * j + 1]};
          const f32x2v nr = ar[sh] * xr[sh] + br2 - ai[sh] * xi[sh], ni = ar[sh] * xi[sh] + bi2 + ai[sh] * xr[sh]; xr[sh] = nr; xi[sh] = ni; }
      }
    }
    const int cidx0 = 4 * wid + 2 * hl;
#pragma unroll
    for (int sh = 0; sh < 2; ++sh) {
      E[(cidx0 * 64 + r + 32 * sh) * 2] = xr[sh].x; E[(cidx0 * 64 + r + 32 * sh) * 2 + 1] = xi[sh].x;
      E[((cidx0 + 1) * 64 + r + 32 * sh) * 2] = xr[sh].y; E[((cidx0 + 1) * 64 + r + 32 * sh) * 2 + 1] = xi[sh].y;
    }
    __syncthreads();
    {
      float sr[2] = {0.f, 0.f}, si[2] = {0.f, 0.f};
#pragma unroll 1
      for (int c2 = 0; c2 < 30; ++c2) {
        if (c2 < cidx0) {
#pragma unroll
          for (int sh = 0; sh < 2; ++sh) {
            const float er = E[(c2 * 64 + r + 32 * sh) * 2], ei = E[(c2 * 64 + r + 32 * sh) * 2 + 1];
            const float nr = a256r[sh] * sr[sh] - a256i[sh] * si[sh] + er, ni = a256r[sh] * si[sh] + a256i[sh] * sr[sh] + ei; sr[sh] = nr; si[sh] = ni;
          }
        }
      }
#pragma unroll
      for (int sh = 0; sh < 2; ++sh) {
        const float e0r = xr[sh].x, e0i = xi[sh].x;
        const float s1r = a256r[sh] * sr[sh] - a256i[sh] * si[sh] + e0r, s1i = a256r[sh] * si[sh] + a256i[sh] * sr[sh] + e0i;
        xr[sh] = (f32x2v){sr[sh], s1r}; xi[sh] = (f32x2v){si[sh], s1i};
      }
    }
    {
      const f32x4 z4 = {0.f, 0.f, 0.f, 0.f};
#pragma unroll
      for (int t = 0; t < 16; ++t) {
        *(bf16x8*)(xw + (hs_r * 16 + tau_r) * XP + 256 + 16 * hl) = afr[t];
#pragma unroll
        for (int sh = 0; sh < 2; ++sh) {
          const f32x16 bur = __builtin_amdgcn_mfma_f32_32x32x16_bf16(afr[t], Bre[sh], z16, 0, 0, 0);
          const f32x16 bui = __builtin_amdgcn_mfma_f32_32x32x16_bf16(afr[t], Bim[sh], z16, 0, 0, 0);
#pragma unroll
          for (int j = 0; j < 8; ++j) {
            const f32x2v br2 = {bur[2 * j], bur[2 * j + 1]}, bi2 = {bui[2 * j], bui[2 * j + 1]};
            const f32x2v nr = ar[sh] * xr[sh] + br2 - ai[sh] * xi[sh], ni = ar[sh] * xi[sh] + bi2 + ai[sh] * xr[sh]; xr[sh] = nr; xi[sh] = ni;
            *(unsigned*)(xw + (hl * 16 + 2 * j) * XP + (r + 32 * sh) * 4) = pk_bf16(nr.x, ni.x);
            *(unsigned*)(xw + (hl * 16 + 2 * j + 1) * XP + (r + 32 * sh) * 4) = pk_bf16(nr.y, ni.y);
          }
        }
        asm volatile("s_waitcnt lgkmcnt(0)" ::: "memory");
#pragma unroll
        for (int mt = 0; mt < 2; ++mt) {
          f32x4 acc = z4;
#pragma unroll
          for (int ks = 0; ks < 4; ++ks) {
            const bf16x8 xa = *(const bf16x8*)(xw + (mt * 16 + pch) * XP + (32 * ks + 8 * kq) * 2);
            acc = __builtin_amdgcn_mfma_f32_16x16x32_bf16(xa, Cf[ks], acc, 0, 0, 0);
          }
          { const bf16x8 ua = *(const bf16x8*)(xw + (mt * 16 + pch) * XP + uaoff);
            acc = __builtin_amdgcn_mfma_f32_16x16x32_bf16(ua, Df, acc, 0, 0, 0); }
#pragma unroll
          for (int i = 0; i < 4; ++i) {
            const float y = gelu_tanh(acc[i]);
            *(bf16_t*)(yb + (unsigned)(((128 * (2 * mt + ((4 * kq + i) & 1)) + 8 * t + ((4 * kq + i) >> 1)) * 512 + pch) * 2)) = (bf16_t)(pk_bf16(y, 0.f) & 0xffffu);
          }
        }
        asm volatile("s_waitcnt lgkmcnt(0)" ::: "memory");
      }
    }
  }
  __syncthreads();
}

DI int pi_row(int r) { const int hh = (r >> 2) & 1, i = (r & 3) + 4 * (r >> 3); return 16 * (i >> 3) + 8 * hh + (i & 7); }
DI int crow16(int i, int hh) { return (i & 3) + 8 * (i >> 2) + 4 * hh; }
__device__ void phase_attn(const Params& P, int bid, int nb) {
  extern __shared__ __attribute__((aligned(16))) unsigned char sm[];
  constexpr int KP = 272, VP = 272, KBYTES = 128 * KP, VBYTES = 128 * VP, BUF = KBYTES + VBYTES, YOFF = BUF, YP = 272;
  int tid = threadIdx.x; asm volatile("" : "+v"(tid));
  const int lane = tid & 63, wid = __builtin_amdgcn_readfirstlane(tid >> 6), c = wid >> 2, qs = wid & 3, r = lane & 31, hl = lane >> 5;
  float mq, mk, s1, s2;
  { mq = fabsf(P.qnw[lane]); mk = fabsf(P.knw[lane]); s1 = P.lq1[lane] * P.lk1[lane]; s2 = P.lq2[lane] * P.lk2[lane];
#pragma unroll
    for (int o = 1; o < 64; o <<= 1) { mq = fmaxf(mq, __shfl_xor(mq, o)); mk = fmaxf(mk, __shfl_xor(mk, o)); s1 += __shfl_xor(s1, o); s2 += __shfl_xor(s2, o); } }
  const float lam = __expf(s1) - __expf(s2) + 0.2f;
  const float nmb = -8.0f * mq * mk * LOG2E;
  const int pir = pi_row(r);
  const int vb = (nb % 8 == 0) ? (bid % 8) * (nb / 8) + bid / 8 : bid;
  for (int pid = vb; pid < 512; pid += nb) {
    const int bh = pid >> 4, kk = pid & 15, b = bh >> 2, h = bh & 3;
#pragma unroll 1
    for (int half = 0; half < 2; ++half) {
      const int qb = half ? kk : 31 - kk, q0 = qb * 128, qw0 = q0 + 32 * qs;
      const size_t tok0 = (size_t)b * SEQ;
      bf16x8 qf[4];
#pragma unroll
      for (int ks = 0; ks < 4; ++ks) qf[ks] = *(const bf16x8*)((const char*)(P.Qb + (tok0 + qw0) * 512 + h * 128 + c * 64) + (unsigned)((r * 512 + ks * 16 + hl * 8) * 2));
      const bf16_t* kg = P.Kb + tok0 * 512 + h * 128;
      const bf16_t* vg = P.Vt + ((size_t)(b * 512 + h * 128)) * 4096;
      u32x4 st[8];
      int t3 = tid; asm volatile("" : "+v"(t3));
      const unsigned koff = (unsigned)((t3 >> 4) * 512 + (t3 & 15) * 8) * 2u, voff_ = (unsigned)((t3 >> 4) * 4096 + (t3 & 15) * 8) * 2u;
      const unsigned klds = (unsigned)((t3 >> 4) * KP + (t3 & 15) * 16), vlds = (unsigned)(KBYTES + (t3 >> 4) * VP + (t3 & 15) * 16);
      const int nst = qb + 1;
#pragma unroll
      for (int i = 0; i < 4; ++i) { st[i] = *(const u32x4*)((const char*)kg + koff + (unsigned)(i * 32 * 1024)); st[4 + i] = *(const u32x4*)((const char*)vg + voff_ + (unsigned)(i * 32 * 8192)); }
#pragma unroll
      for (int i = 0; i < 4; ++i) { *(u32x4*)(sm + klds + i * 32 * KP) = st[i]; *(u32x4*)(sm + vlds + i * 32 * VP) = st[4 + i]; }
      __syncthreads();
      f32x16 o[4];
#pragma unroll
      for (int dt = 0; dt < 4; ++dt)
#pragma unroll
        for (int i = 0; i < 16; ++i) o[dt][i] = 0.f;
      float l = 0.f;
#pragma unroll 1
      for (int stp = 0; stp < nst; ++stp) {
        const bool more = (stp + 1 < nst);
        if (more) {
#pragma unroll
          for (int i = 0; i < 4; ++i) { st[i] = *(const u32x4*)((const char*)kg + (size_t)(stp + 1) * (128 * 1024) + koff + (unsigned)(i * 32 * 1024)); st[4 + i] = *(const u32x4*)((const char*)vg + (size_t)(stp + 1) * 256 + voff_ + (unsigned)(i * 32 * 8192)); }
        }
        const unsigned char* bbuf = sm + (stp & 1) * BUF;
#pragma unroll
        for (int sub = 0; sub < 2; ++sub) {
        const int kt = 2 * stp + sub;
        if (64 * kt <= qw0 + 31) {
          const unsigned char* kbuf = bbuf + sub * 64 * KP; const unsigned char* vbuf = bbuf + KBYTES + sub * 128;
          f32x16 s[2];
#pragma unroll
          for (int i = 0; i < 16; ++i) { s[0][i] = nmb; s[1][i] = nmb; }
          __builtin_amdgcn_s_setprio(1);
#pragma unroll
          for (int ks = 0; ks < 4; ++ks) {
            const bf16x8 k0 = *(const bf16x8*)(kbuf + pir * KP + (c * 64 + ks * 16 + hl * 8) * 2);
            const bf16x8 k1 = *(const bf16x8*)(kbuf + (32 + pir) * KP + (c * 64 + ks * 16 + hl * 8) * 2);
            s[0] = __builtin_amdgcn_mfma_f32_32x32x16_bf16(k0, qf[ks], s[0], 0, 0, 0);
            s[1] = __builtin_amdgcn_mfma_f32_32x32x16_bf16(k1, qf[ks], s[1], 0, 0, 0);
          }
          __builtin_amdgcn_s_setprio(0);
          if (64 * kt + 63 > qw0) {
            asm volatile("" ::: "memory");
#pragma unroll
            for (int mt = 0; mt < 2; ++mt)
#pragma unroll
              for (int i = 0; i < 16; ++i) { const int key = 64 * kt + 32 * mt + 16 * (i >> 3) + 8 * hl + (i & 7); s[mt][i] = (key <= qw0 + r) ? s[mt][i] : -1.0e30f; }
            asm volatile("" ::: "memory");
          }
          bf16x8 pb[2][2];
#pragma unroll
          for (int mt = 0; mt < 2; ++mt) {
            float pv[16];
#pragma unroll
            for (int i = 0; i < 16; ++i) { const float e = __builtin_amdgcn_exp2f(s[mt][i]); pv[i] = e; l += e; }
#pragma unroll
            for (int sp = 0; sp < 2; ++sp) {
              u32x4 w; w.x = pk_bf16(pv[8 * sp], pv[8 * sp + 1]); w.y = pk_bf16(pv[8 * sp + 2], pv[8 * sp + 3]); w.z = pk_bf16(pv[8 * sp + 4], pv[8 * sp + 5]); w.w = pk_bf16(pv[8 * sp + 6], pv[8 * sp + 7]);
              pb[mt][sp] = __builtin_bit_cast(bf16x8, w);
            }
          }
          {
            bf16x8 vc[4], vn[4];
#pragma unroll
            for (int dt = 0; dt < 4; ++dt) vc[dt] = *(const bf16x8*)(vbuf + (32 * dt + r) * VP + (8 * hl) * 2);
#pragma unroll
            for (int g = 0; g < 4; ++g) {
              if (g < 3) {
#pragma unroll
                for (int dt = 0; dt < 4; ++dt) vn[dt] = *(const bf16x8*)(vbuf + (32 * dt + r) * VP + (16 * (g + 1) + 8 * hl) * 2);
              }
              __builtin_amdgcn_sched_barrier(0);
              __builtin_amdgcn_s_setprio(1);
#pragma unroll
              for (int dt = 0; dt < 4; ++dt) o[dt] = __builtin_amdgcn_mfma_f32_32x32x16_bf16(vc[dt], pb[g >> 1][g & 1], o[dt], 0, 0, 0);
              __builtin_amdgcn_s_setprio(0);
              __builtin_amdgcn_sched_barrier(0);
              if (g < 3) {
#pragma unroll
                for (int dt = 0; dt < 4; ++dt) vc[dt] = vn[dt];
              }
            }
          }
        }
        }
        if (more) {
          unsigned char* nb_ = sm + ((stp + 1) & 1) * BUF;
#pragma unroll
          for (int i = 0; i < 4; ++i) { *(u32x4*)(nb_ + klds + i * 32 * KP) = st[i]; *(u32x4*)(nb_ + vlds + i * 32 * VP) = st[4 + i]; }
        }
        __syncthreads();
      }
      l += __shfl_xor(l, 32);
      const float inv = 1.0f / l;
      float* oex = (float*)sm;
      if (c == 1) {
#pragma unroll
        for (int dt = 0; dt < 4; ++dt)
#pragma unroll
          for (int i = 0; i < 16; ++i) oex[(qs * 128 + 32 * dt + crow16(i, hl)) * 32 + r] = o[dt][i] * inv;
      }
      __syncthreads();
      if (c == 0) {
        float ss = 0.f;
#pragma unroll
        for (int dt = 0; dt < 4; ++dt)
#pragma unroll
          for (int i = 0; i < 16; ++i) { const float v = o[dt][i] * inv - lam * oex[(qs * 128 + 32 * dt + crow16(i, hl)) * 32 + r]; o[dt][i] = v; ss += v * v; }
        ss += __shfl_xor(ss, 32);
        const float rs = rsqrtf(ss * (1.0f / 128.0f) + 1e-6f) * 0.8f;
#pragma unroll
        for (int dt = 0; dt < 4; ++dt)
#pragma unroll
          for (int g = 0; g < 4; ++g) {
            const int dv0 = 32 * dt + 8 * g + 4 * hl;
            const f32x4 wv = *(const f32x4*)(P.subln_w + dv0);
            u32x2 w; w.x = pk_bf16(o[dt][4 * g] * rs * wv[0], o[dt][4 * g + 1] * rs * wv[1]); w.y = pk_bf16(o[dt][4 * g + 2] * rs * wv[2], o[dt][4 * g + 3] * rs * wv[3]);
            *(u32x2*)(sm + YOFF + (32 * qs + r) * YP + dv0 * 2) = w;
          }
      }
      __syncthreads();
      int t4 = tid; asm volatile("" : "+v"(t4));
      const char* zab = (const char*)(P.Za + (tok0 + q0) * 512 + h * 128);
      char* ycb = (char*)(P.Ycat + (tok0 + q0) * 1024 + 512 + h * 128);
#pragma unroll
      for (int i = 0; i < 4; ++i) {
        const int id = t4 + 512 * i, row = id >> 4, ch = id & 15;
        const u32x4 y8 = *(const u32x4*)(sm + YOFF + row * YP + ch * 16);
        const u32x4 za = *(const u32x4*)(zab + (unsigned)(row * 1024 + ch * 16));
        u32x4 w;
        w.x = pk_bf16(bflo(y8.x) * bflo(za.x), bfhi(y8.x) * bfhi(za.x)); w.y = pk_bf16(bflo(y8.y) * bflo(za.y), bfhi(y8.y) * bfhi(za.y));
        w.z = pk_bf16(bflo(y8.z) * bflo(za.z), bfhi(y8.z) * bfhi(za.z)); w.w = pk_bf16(bflo(y8.w) * bflo(za.w), bfhi(y8.w) * bfhi(za.w));
        *(u32x4*)(ycb + (unsigned)(row * 2048 + ch * 16)) = w;
      }
    }
  }
  __syncthreads();
}

__device__ void phase3(const Params& P, int bid, int nb) { SrcGlu s{&P, bid, nb}; gemm_stream<512, 4>(P, s); }
__device__ void phase4(const Params& P, int bid, int nb) {
  const bool ple_first = ((bid >> 3) & 1) != 0;
  SrcPle sp{&P, bid, nb}; SrcN1024 so{P.Ycat, P.WtOut, 8, bid, nb};
  if (ple_first) gemm_stream<256, 1>(P, sp);
  gemm_stream<1024, 8>(P, so);
  if (!ple_first) gemm_stream<256, 1>(P, sp);
}
__device__ void phase5(const Params& P, int bid, int nb) { SrcN1024 s{P.X1b, P.WtG, 9, bid, nb}; gemm_stream<1024, 16>(P, s); }

__global__ void __launch_bounds__(NTHR, 2) mega(Params P, int plo, int phi) {
  const int bid = blockIdx.x, nb = gridDim.x;
#define IN(k) (plo <= (k) && (k) < phi)
  extern __shared__ __attribute__((aligned(16))) unsigned char smk[];
  volatile LAS unsigned* xst = (volatile LAS unsigned*)(smk + LDS_BYTES);
  if (threadIdx.x < 4) xst[threadIdx.x] = 0u;
  __syncthreads();
  XcdBarrier xbar = xcd_barrier_post(P.barw, xst);
  if (plo > 1000) cg::this_grid().sync();
#define SEAM(k) do { if (IN(k) && IN((k) + 1)) xcd_barrier(xbar); } while (0)
#ifndef REP
#define REP -1
#endif
#define GS() xcd_barrier(xbar)
  if (IN(0)) { phase0(P, bid, nb); if (REP == 0) { GS(); phase0(P, bid, nb); } }
  SEAM(0);
  if (IN(1)) { phase1(P, bid, nb); if (REP == 1) { GS(); phase1(P, bid, nb); } }
  SEAM(1);
  if (IN(2)) { phase_ssm(P, bid, nb); if (REP == 2) { GS(); phase_ssm(P, bid, nb); } phase_attn(P, bid, nb); if (REP == 6) { GS(); phase_attn(P, bid, nb); } }
  SEAM(2);
  if (IN(3)) { phase3(P, bid, nb); if (REP == 3) { GS(); phase3(P, bid, nb); } }
  SEAM(3);
  if (IN(4)) { phase4(P, bid, nb); if (REP == 4) { GS(); phase4(P, bid, nb); } }
  SEAM(4);
  if (IN(5)) phase5(P, bid, nb);
  if (REP == 5) { GS(); phase4(P, bid, nb); GS(); phase5(P, bid, nb); }
}

#ifndef N_LAUNCH_MODE
#define N_LAUNCH_MODE 1
#endif

extern "C" void kernel_launch(void* const* d_in, const int* in_sizes, int n_in, void* d_out, int out_size, void* d_ws, size_t ws_size, hipStream_t stream) {
  Params P{};
  P.x = (const float*)d_in[0]; P.p = (const float*)d_in[1]; P.pos = (const int*)d_in[2];
  P.norm_w = (const float*)d_in[3]; P.w_in = (const float*)d_in[4]; P.lam_re = (const float*)d_in[5]; P.lam_im = (const float*)d_in[6];
  P.log_dt = (const float*)d_in[7]; P.b_re = (const float*)d_in[8]; P.b_im = (const float*)d_in[9]; P.c_re = (const float*)d_in[10]; P.c_im = (const float*)d_in[11];
  P.ssm_d = (const float*)d_in[12]; P.glu_w = (const float*)d_in[13]; P.glu_b = (const float*)d_in[14]; P.qnw = (const float*)d_in[15]; P.knw = (const float*)d_in[16];
  P.lq1 = (const float*)d_in[17]; P.lk1 = (const float*)d_in[18]; P.lq2 = (const float*)d_in[19]; P.lk2 = (const float*)d_in[20]; P.subln_w = (const float*)d_in[21];
  P.w_out = (const float*)d_in[22]; P.wp = (const float*)d_in[23]; P.wg = (const float*)d_in[24];
  P.out = (float*)d_out;
  char* w = (char*)d_ws; size_t off = 16384;
  P.barw = (unsigned*)d_ws;
  auto take = [&](size_t bytes) { char* r = w + off; off += (bytes + 255) & ~(size_t)255; return (bf16_t*)r; };
  P.Hb = take((size_t)NTOK * 1024 * 2); P.X1b = P.Hb;
  P.WtIn = take((size_t)3072 * 1024 * 2); P.WtGlu = take((size_t)512 * 512 * 2); P.WtOut = take((size_t)1024 * 1024 * 2);
  P.WtP = take((size_t)1024 * 256 * 2); P.WtG = take((size_t)1024 * 1024 * 2);
  P.Pb = take((size_t)NTOK * 256 * 2);
  P.U = take((size_t)NTOK * 512 * 2); P.Zs = take((size_t)NTOK * 512 * 2); P.Qb = take((size_t)NTOK * 512 * 2); P.Kb = take((size_t)NTOK * 512 * 2);
  P.Vt = take((size_t)NTOK * 512 * 2); P.Za = take((size_t)NTOK * 512 * 2); P.Yg = take((size_t)NTOK * 512 * 2);
  P.Ycat = take((size_t)NTOK * 1024 * 2); P.PP = take((size_t)NTOK * 1024 * 2);
  P.rope = (float*)take((size_t)NTOK * 16 * 4);

  static int grid_blocks = 0;
  if (!grid_blocks) {
    hipFuncSetAttribute((const void*)mega, hipFuncAttributeMaxDynamicSharedMemorySize, LDS_BYTES + 256);
    int dev = 0, cus = 0, per_cu = 0;
    hipGetDevice(&dev);
    hipDeviceGetAttribute(&cus, hipDeviceAttributeMultiprocessorCount, dev);
    hipOccupancyMaxActiveBlocksPerMultiprocessor(&per_cu, mega, NTHR, LDS_BYTES + 256);
    if (per_cu < 1) per_cu = 1;
    grid_blocks = cus;
  }
#if N_LAUNCH_MODE == 1
  hipMemsetAsync(d_ws, 0, 16384, stream);
  int plo = 0, phi = 6;
  void* args[] = {&P, &plo, &phi};
  hipError_t e = hipLaunchCooperativeKernel((void*)mega, dim3(grid_blocks), dim3(NTHR), args, LDS_BYTES + 256, stream);
  if (e != hipSuccess) fprintf(stderr, "cooperative launch failed: %s (grid %d)\n", hipGetErrorString(e), grid_blocks);
#else
  for (int ph = 0; ph < 6; ++ph) hipLaunchKernelGGL(mega, dim3(grid_blocks), dim3(NTHR), LDS_BYTES, stream, P, ph, ph + 1);
#endif
}
```

```cpp
#include <hip/hip_runtime.h>
#include <hip/hip_cooperative_groups.h>
#include <stdint.h>
#include <cstdio>
namespace cg = cooperative_groups;

typedef unsigned short bf16_t;
typedef short bf16x8 __attribute__((ext_vector_type(8)));
typedef float f32x4 __attribute__((ext_vector_type(4)));
typedef float f32x16 __attribute__((ext_vector_type(16)));
typedef unsigned u32x4 __attribute__((ext_vector_type(4)));
typedef unsigned u32x2 __attribute__((ext_vector_type(2)));

#define NTOK 32768
#define SEQ 4096
#define DM 1024
#define INC 3072
#define NTHR 512
#define LDS_BYTES 139264
#define LOG2E 1.4426950408889634f

struct Params {
  const float *x, *p; const int* pos;
  const float *norm_w, *w_in, *lam_re, *lam_im, *log_dt, *b_re, *b_im, *c_re, *c_im, *ssm_d, *glu_w, *glu_b,
      *qnw, *knw, *lq1, *lk1, *lq2, *lk2, *subln_w, *w_out, *wp, *wg;
  float* out;
  float* rope; unsigned* barw;
  bf16_t *Hb, *WtIn, *WtGlu, *WtOut, *WtP, *WtG, *Pb, *U, *Zs, *Qb, *Kb, *Vt, *Za, *Yg, *Ycat, *X1b, *PP;
};

#define DI __device__ __forceinline__
DI unsigned pk_bf16(float lo, float hi) { unsigned r; asm("v_cvt_pk_bf16_f32 %0, %1, %2" : "=v"(r) : "v"(lo), "v"(hi)); return r; }
DI float bflo(unsigned w) { return __uint_as_float(w << 16); }
DI float bfhi(unsigned w) { return __uint_as_float(w & 0xffff0000u); }
DI float bf2f(bf16_t v) { return __uint_as_float(((unsigned)v) << 16); }
DI float sigmoidf_(float v) { return __builtin_amdgcn_rcpf(1.0f + __builtin_amdgcn_exp2f(-LOG2E * v)); }
DI float siluf_(float v) { return v * __builtin_amdgcn_rcpf(1.0f + __builtin_amdgcn_exp2f(-LOG2E * v)); }
DI float gelu_tanh(float v) { float u = 0.7978845608028654f * (v + 0.044715f * v * v * v); return v * __builtin_amdgcn_rcpf(1.0f + __builtin_amdgcn_exp2f(-2.0f * LOG2E * u)); }
DI void store16bf(bf16_t* dst, const f32x4 (&v)[4]) {
  u32x4 a, b;
  a.x = pk_bf16(v[0][0], v[0][1]); a.y = pk_bf16(v[0][2], v[0][3]); a.z = pk_bf16(v[1][0], v[1][1]); a.w = pk_bf16(v[1][2], v[1][3]);
  b.x = pk_bf16(v[2][0], v[2][1]); b.y = pk_bf16(v[2][2], v[2][3]); b.z = pk_bf16(v[3][0], v[3][1]); b.w = pk_bf16(v[3][2], v[3][3]);
  *(u32x4*)dst = a; *(u32x4*)(dst + 8) = b;
}
DI void cvt16bf(const u32x4 a, const u32x4 b, f32x4 (&v)[4]) {
  v[0] = (f32x4){bflo(a.x), bfhi(a.x), bflo(a.y), bfhi(a.y)}; v[1] = (f32x4){bflo(a.z), bfhi(a.z), bflo(a.w), bfhi(a.w)};
  v[2] = (f32x4){bflo(b.x), bfhi(b.x), bflo(b.y), bfhi(b.y)}; v[3] = (f32x4){bflo(b.z), bfhi(b.z), bflo(b.w), bfhi(b.w)};
}
DI void load16bf(const bf16_t* src, f32x4 (&v)[4]) {
  u32x4 a = *(const u32x4*)src, b = *(const u32x4*)(src + 8);
  v[0] = (f32x4){bflo(a.x), bfhi(a.x), bflo(a.y), bfhi(a.y)}; v[1] = (f32x4){bflo(a.z), bfhi(a.z), bflo(a.w), bfhi(a.w)};
  v[2] = (f32x4){bflo(b.x), bfhi(b.x), bflo(b.y), bfhi(b.y)}; v[3] = (f32x4){bflo(b.z), bfhi(b.z), bflo(b.w), bfhi(b.w)};
}

#define XB_TMO      128
#define XB_XCNT(j)  (256  + 64 * (j))
#define XB_XSUB(j)  (1280 + 64 * (j))
#define XB_XGEN(j)  (2304 + 64 * (j))
#define XB_TOP      3328
#define XB_TOPGEN   3392
#define XCD_BAR_WORDS 3456
#define XB_SPIN_CAP (1u << 18)
#define LAS __attribute__((address_space(3)))
DI unsigned xb_ld(unsigned* p) { return __hip_atomic_load(p, __ATOMIC_RELAXED, __HIP_MEMORY_SCOPE_AGENT); }
DI unsigned xb_add(unsigned* p, unsigned v) { return __hip_atomic_fetch_add(p, v, __ATOMIC_RELAXED, __HIP_MEMORY_SCOPE_AGENT); }
DI unsigned xb_xcc_id() { return (unsigned)__builtin_amdgcn_s_getreg((3 << 11) | 20) & 0xFu; }
#define XB_SPIN(cond, bar) do { unsigned _sp = 0; while (cond) { __builtin_amdgcn_s_sleep(1); \
    if ((++_sp & 255u) == 0u) { if (xb_ld(&(bar)[XB_TMO])) break; if (_sp > XB_SPIN_CAP) { atomicAdd(&(bar)[XB_TMO], 1u); break; } } } } while (0)
struct XcdBarrier { unsigned* bar; unsigned x; volatile LAS unsigned* st; };
DI XcdBarrier xcd_barrier_post(unsigned* bar, volatile LAS unsigned* st) {
  XcdBarrier b; b.bar = bar; b.x = xb_xcc_id(); b.st = st;
  if (threadIdx.x == 0) (void)xb_add(&bar[XB_XCNT(b.x)], 1u);
  return b;
}
DI void xcd_barrier_complete(unsigned* bar, unsigned x, unsigned& nloc, unsigned& nx) {
  const unsigned G = gridDim.x * gridDim.y * gridDim.z;
  unsigned sum, cnt, mine, sp = 0u;
  for (;;) {
    sum = 0u; cnt = 0u; mine = 0u;
#pragma unroll
    for (unsigned j = 0; j < 16; ++j) { const unsigned c = xb_ld(&bar[XB_XCNT(j)]); sum += c; cnt += (c > 0u) ? 1u : 0u; mine = (j == x) ? c : mine; }
    if (sum == G) break;
    __builtin_amdgcn_s_sleep(1);
    if ((++sp & 255u) == 0u) { if (xb_ld(&bar[XB_TMO])) break; if (sp > XB_SPIN_CAP) { atomicAdd(&bar[XB_TMO], 1u); break; } }
  }
  nloc = mine > 0u ? mine : 1u; nx = cnt > 0u ? cnt : 1u;
}
DI void xcd_barrier(const XcdBarrier& b) {
  asm volatile("s_waitcnt vmcnt(0)" ::: "memory");
  __syncthreads();
  if (threadIdx.x == 0) {
    unsigned* bar = b.bar;
    __builtin_amdgcn_s_waitcnt(0);
    unsigned nloc = b.st[0], nx = b.st[1];
    if (nloc == 0u) { xcd_barrier_complete(bar, b.x, nloc, nx); b.st[0] = nloc; b.st[1] = nx; }
    const unsigned old = xb_add(&bar[XB_XSUB(b.x)], 1u);
    const unsigned gen = old / nloc;
    if (old + 1u == (gen + 1u) * nloc) {
      __builtin_amdgcn_fence(__ATOMIC_RELEASE, "agent");
      asm volatile("s_waitcnt vmcnt(0)" ::: "memory");
      const unsigned og = xb_add(&bar[XB_TOP], 1u);
      const unsigned tg = og / nx;
      if (og + 1u == (tg + 1u) * nx) xb_add(&bar[XB_TOPGEN], 1u);
      else XB_SPIN(xb_ld(&bar[XB_TOPGEN]) == tg, bar);
      __builtin_amdgcn_fence(__ATOMIC_ACQUIRE, "agent");
      xb_add(&bar[XB_XGEN(b.x)], 1u);
      asm volatile("s_waitcnt vmcnt(0)" ::: "memory");
    } else {
      XB_SPIN(xb_ld(&bar[XB_XGEN(b.x)]) == gen, bar);
      __builtin_amdgcn_fence(__ATOMIC_ACQUIRE, "agent");
      asm volatile("s_waitcnt vmcnt(0)" ::: "memory");
    }
  }
  __syncthreads();
}

constexpr int BM = 256, BK = 64, HALF = 128, HTB = HALF * BK * 2;
DI int lds_byte(int r, int c) { int st = (r >> 4) * 2 + (c >> 5), rr = r & 15, cc = c & 31, ob = rr * 64 + cc * 2; return st * 1024 + (ob ^ (((ob >> 9) & 1) << 5)); }
DI void stage_rc(int b, int& R, int& C) { int st = b / 1024, sb = b % 1024, swz = sb ^ (((sb >> 9) & 1) << 5); R = (st >> 1) * 16 + swz / 64; C = (st & 1) * 32 + (swz % 64) / 2; }
DI int perm32(int rho) { const int n = rho >> 4, i = rho & 15; return 8 * (i >> 2) + 4 * n + (i & 3); }
struct GUnit { const char* a; const char* b; int rowbase, colbase, mode; };

DI void st8(bf16_t* dst, const f32x4 a, const f32x4 b) {
  u32x4 w; w.x = pk_bf16(a[0], a[1]); w.y = pk_bf16(a[2], a[3]); w.z = pk_bf16(b[0], b[1]); w.w = pk_bf16(b[2], b[3]);
  *(u32x4*)dst = w;
}
DI void cv8(const u32x4 a, f32x4& lo, f32x4& hi) { lo = (f32x4){bflo(a.x), bfhi(a.x), bflo(a.y), bfhi(a.y)}; hi = (f32x4){bflo(a.z), bfhi(a.z), bflo(a.w), bfhi(a.w)}; }

template <int MS>
DI void epi_regs(const Params& P, const GUnit& u, f32x4 (&acc)[2][2][4][2], int wr, int wc, int fr, int fq) {
  const int mode = u.mode;
  const int rb = u.rowbase + 64 * wr + fr, cb = u.colbase + 64 * wc + 8 * fq;
  if ((MS & 1) && (mode == 0 || mode == 1 || mode == 5 || mode == 6 || mode == 4)) {
#pragma unroll
    for (int ai = 0; ai < 2; ++ai)
#pragma unroll
      for (int m = 0; m < 4; ++m)
#pragma unroll
        for (int bj = 0; bj < 2; ++bj) {
          const int row = rb + 128 * ai + 16 * m, col = cb + 32 * bj;
          f32x4 v0 = acc[ai][bj][m][0], v1 = acc[ai][bj][m][1];
          if (mode == 1 || mode == 5) {
#pragma unroll
            for (int j = 0; j < 4; ++j) { v0[j] = siluf_(v0[j]); v1[j] = siluf_(v1[j]); }
          }
          bf16_t* dst;
          if (mode == 0) dst = P.U + (size_t)row * 512 + col;
          else if (mode == 1) dst = P.Zs + (size_t)row * 512 + (col - 512);
          else if (mode == 5) dst = P.Za + (size_t)row * 512 + (col - 2560);
          else if (mode == 6) dst = P.PP + (size_t)row * 1024 + col;
          else dst = P.Vt + ((size_t)((col >> 12) * 512 + row)) * 4096 + (col & 4095);
          st8(dst, v0, v1);
        }
  } else if ((MS & 2) && (mode == 2 || mode == 3)) {
    const float* w = (mode == 2) ? P.qnw : P.knw;
    const f32x4 w00 = *(const f32x4*)(w + 8 * fq), w01 = *(const f32x4*)(w + 8 * fq + 4), w10 = *(const f32x4*)(w + 32 + 8 * fq), w11 = *(const f32x4*)(w + 32 + 8 * fq + 4);
    const float sgn = (fq == 0) ? -1.0f : 1.0f;
    const float osc = (mode == 2) ? (0.125f * LOG2E) : 1.0f;
#pragma unroll
    for (int ai = 0; ai < 2; ++ai)
#pragma unroll
      for (int m = 0; m < 4; ++m) {
        const int row = rb + 128 * ai + 16 * m;
        f32x4 a0 = acc[ai][0][m][0], a1 = acc[ai][0][m][1], b0 = acc[ai][1][m][0], b1 = acc[ai][1][m][1];
        float ss = 0.f;
#pragma unroll
        for (int j = 0; j < 4; ++j) ss += a0[j] * a0[j] + a1[j] * a1[j] + b0[j] * b0[j] + b1[j] * b1[j];
        ss += __shfl_xor(ss, 16); ss += __shfl_xor(ss, 32);
        const float rs = rsqrtf(ss * (1.0f / 64.0f) + 1e-6f);
        a0 = a0 * rs * w00; a1 = a1 * rs * w01; b0 = b0 * rs * w10; b1 = b1 * rs * w11;
        f32x4 p0, p1;
#pragma unroll
        for (int j = 0; j < 4; ++j) { p0[j] = __shfl_xor(a0[j], 16); p1[j] = __shfl_xor(a1[j], 16); }
        if (fq < 2) {
          const f32x4* rt = (const f32x4*)(P.rope + (size_t)row * 16);
          const f32x4 t0 = rt[0], t1 = rt[1], t2 = rt[2], t3 = rt[3];
          a0[0] = a0[0] * t0[0] + sgn * p0[0] * t0[1]; a0[1] = a0[1] * t0[2] + sgn * p0[1] * t0[3];
          a0[2] = a0[2] * t1[0] + sgn * p0[2] * t1[1]; a0[3] = a0[3] * t1[2] + sgn * p0[3] * t1[3];
          a1[0] = a1[0] * t2[0] + sgn * p1[0] * t2[1]; a1[1] = a1[1] * t2[2] + sgn * p1[1] * t2[3];
          a1[2] = a1[2] * t3[0] + sgn * p1[2] * t3[1]; a1[3] = a1[3] * t3[2] + sgn * p1[3] * t3[3];
        }
        a0 = a0 * osc; a1 = a1 * osc; b0 = b0 * osc; b1 = b1 * osc;
        bf16_t* dst = ((mode == 2) ? P.Qb : P.Kb) + (size_t)row * 512 + (cb - ((mode == 2) ? 1024 : 1536));
        st8(dst, a0, a1); st8(dst + 32, b0, b1);
      }
  } else if ((MS & 4) && mode == 7) {
#pragma unroll
    for (int ai = 0; ai < 2; ++ai) {
      u32x4 yg[4][2], zs[4][2];
#pragma unroll
      for (int m = 0; m < 4; ++m)
#pragma unroll
        for (int bj = 0; bj < 2; ++bj) { const size_t o = (size_t)(rb + 128 * ai + 16 * m) * 512 + cb + 32 * bj; yg[m][bj] = *(const u32x4*)(P.Yg + o); zs[m][bj] = *(const u32x4*)(P.Zs + o); }
#pragma unroll
      for (int m = 0; m < 4; ++m)
#pragma unroll
        for (int bj = 0; bj < 2; ++bj) {
          const int row = rb + 128 * ai + 16 * m, col = cb + 32 * bj;
          const f32x4 g0 = *(const f32x4*)(P.glu_b + col), g1 = *(const f32x4*)(P.glu_b + col + 4);
          f32x4 y0, y1, z0, z1; cv8(yg[m][bj], y0, y1); cv8(zs[m][bj], z0, z1);
          f32x4 v0 = acc[ai][bj][m][0], v1 = acc[ai][bj][m][1];
#pragma unroll
          for (int j = 0; j < 4; ++j) { v0[j] = y0[j] * sigmoidf_(v0[j] + g0[j]) * z0[j]; v1[j] = y1[j] * sigmoidf_(v1[j] + g1[j]) * z1[j]; }
          st8(P.Ycat + (size_t)row * 1024 + col, v0, v1);
        }
    }
  } else if ((MS & 8) && mode == 8) {
#pragma unroll
    for (int ai = 0; ai < 2; ++ai)
#pragma unroll
      for (int mh = 0; mh < 2; ++mh) {
        f32x4 xv[2][2][2];
#pragma unroll
        for (int mm = 0; mm < 2; ++mm)
#pragma unroll
          for (int bj = 0; bj < 2; ++bj) { const size_t o = (size_t)(rb + 128 * ai + 16 * (2 * mh + mm)) * 1024 + cb + 32 * bj; xv[mm][bj][0] = *(const f32x4*)(P.x + o); xv[mm][bj][1] = *(const f32x4*)(P.x + o + 4); }
#pragma unroll
        for (int mm = 0; mm < 2; ++mm)
#pragma unroll
          for (int bj = 0; bj < 2; ++bj) { const int m = 2 * mh + mm; const size_t o = (size_t)(rb + 128 * ai + 16 * m) * 1024 + cb + 32 * bj;
            st8(P.X1b + o, acc[ai][bj][m][0] + xv[mm][bj][0], acc[ai][bj][m][1] + xv[mm][bj][1]); }
      }
  } else if ((MS & 16) && mode == 9) {
#pragma unroll
    for (int ai = 0; ai < 2; ++ai) {
      u32x4 xb[4][2], pp[4][2];
#pragma unroll
      for (int m = 0; m < 4; ++m)
#pragma unroll
        for (int bj = 0; bj < 2; ++bj) { const size_t o = (size_t)(rb + 128 * ai + 16 * m) * 1024 + cb + 32 * bj; xb[m][bj] = *(const u32x4*)(P.X1b + o); pp[m][bj] = *(const u32x4*)(P.PP + o); }
#pragma unroll
      for (int m = 0; m < 4; ++m)
#pragma unroll
        for (int bj = 0; bj < 2; ++bj) {
          const size_t o = (size_t)(rb + 128 * ai + 16 * m) * 1024 + cb + 32 * bj;
          f32x4 x0, x1, q0, q1; cv8(xb[m][bj], x0, x1); cv8(pp[m][bj], q0, q1);
          const f32x4 v0 = acc[ai][bj][m][0], v1 = acc[ai][bj][m][1];
#pragma unroll
          for (int j = 0; j < 4; ++j) { x0[j] += sigmoidf_(v0[j]) * q0[j]; x1[j] += sigmoidf_(v1[j]) * q1[j]; }
          *(f32x4*)(P.out + o) = x0; *(f32x4*)(P.out + o + 4) = x1;
        }
    }
  }
}

template <int K, int MS, class Src>
__device__ __forceinline__ void gemm_stream(const Params& P, const Src& S) {
  extern __shared__ __attribute__((aligned(16))) unsigned char lds[];
  int tid = threadIdx.x; asm volatile("" : "+v"(tid));
  const int wid = __builtin_amdgcn_readfirstlane(tid >> 6), lane = tid & 63, wr = wid >> 2, wc = wid & 3, fr = lane & 15, fq = lane >> 4;
  constexpr int nt = K / BK;
  unsigned voffA[2], voffB[2];
#pragma unroll
  for (int i = 0; i < 2; ++i) { int R, C; stage_rc(tid * 16 + i * 8192, R, C); const int Rb = 64 * (R >> 5) + perm32(R & 31);
    voffA[i] = (unsigned)(R * K + C) * 2u; voffB[i] = (unsigned)(Rb * K + C) * 2u; }
  constexpr size_t kstep = (size_t)BK * 2, hstepA = (size_t)HALF * K * 2, hstepB = (size_t)32 * K * 2;
  const int aoff = lds_byte(wr * 64 + fr, fq * 8), boff = lds_byte(wc * 32 + fr, fq * 8);
#define GSA(b, h) (((b) * 2 + (h)) * HTB)
#define GSB(b, h) ((4 + (b) * 2 + (h)) * HTB)
#define GSTAGE(bufoff, gbase, voff) do { _Pragma("unroll") for (int _i = 0; _i < 2; ++_i) \
    __builtin_amdgcn_global_load_lds((const unsigned*)((const char*)(gbase) + (voff)[_i]), (LAS unsigned*)(lds + (bufoff) + tid * 16 + _i * 8192), 16, 0, 0); } while (0)
#define GLDA(dst, b, h) do { _Pragma("unroll") for (int m = 0; m < 4; ++m) _Pragma("unroll") for (int k = 0; k < 2; ++k) dst[m][k] = *(const bf16x8*)(lds + GSA(b, h) + aoff + m * 2048 + k * 1024); } while (0)
#define GLDB(dst, b, h) do { _Pragma("unroll") for (int n = 0; n < 2; ++n) _Pragma("unroll") for (int k = 0; k < 2; ++k) dst[n][k] = *(const bf16x8*)(lds + GSB(b, h) + boff + n * 2048 + k * 1024); } while (0)
#define GMMA(ai, bj, At_, Bt_) do { __builtin_amdgcn_s_setprio(1); _Pragma("unroll") for (int m = 0; m < 4; ++m) _Pragma("unroll") for (int n = 0; n < 2; ++n) _Pragma("unroll") for (int k = 0; k < 2; ++k) \
    acc[ai][bj][m][n] = __builtin_amdgcn_mfma_f32_16x16x32_bf16(Bt_[n][k], At_[m][k], acc[ai][bj][m][n], 0, 0, 0); __builtin_amdgcn_s_setprio(0); } while (0)
#define GWAIT_V(n) asm volatile("s_waitcnt vmcnt(" #n ")" ::: "memory")
#define GWAIT_L(n) asm volatile("s_waitcnt lgkmcnt(" #n ")" ::: "memory")
#define GBAR __builtin_amdgcn_s_barrier()
#define GSCHED __builtin_amdgcn_sched_barrier(0)
  GUnit cur, nxt; int ui = 0;
  if (!S.get(0, cur)) return;
  f32x4 acc[2][2][4][2];
#pragma unroll
  for (int a = 0; a < 2; ++a)
#pragma unroll
    for (int b = 0; b < 2; ++b)
#pragma unroll
      for (int m = 0; m < 4; ++m)
#pragma unroll
        for (int n = 0; n < 2; ++n) acc[a][b][m][n] = (f32x4){0.f, 0.f, 0.f, 0.f};
  bf16x8 At[4][2], B0[2][2], B1[2][2];
  const char* cA = cur.a; const char* cB = cur.b;
  __syncthreads();
#ifndef G_SP2
#define G_SP2 1
#endif
#if G_SP2
  GSTAGE(GSB(0, 0), cB, voffB); GSTAGE(GSB(0, 1), cB + hstepB, voffB); GSTAGE(GSA(0, 0), cA, voffA); GSTAGE(GSA(0, 1), cA + hstepA, voffA);
  if (wr == 1) GBAR;
  GWAIT_V(2); GBAR;
  GSTAGE(GSB(1, 0), cB + kstep, voffB); GSTAGE(GSA(1, 0), cA + kstep, voffA); GSTAGE(GSB(1, 1), cB + hstepB + kstep, voffB);
  GWAIT_V(6); GBAR;
#else
  GSTAGE(GSB(0, 0), cB, voffB); GSTAGE(GSA(0, 0), cA, voffA); GSTAGE(GSB(0, 1), cB + hstepB, voffB); GSTAGE(GSA(0, 1), cA + hstepA, voffA);
  if (wr == 1) GBAR;
  GWAIT_V(4); GBAR;
  GSTAGE(GSB(1, 0), cB + kstep, voffB); GSTAGE(GSA(1, 0), cA + kstep, voffA); GSTAGE(GSB(1, 1), cB + hstepB + kstep, voffB);
  GWAIT_V(6); GBAR;
#endif
  for (;;) {
    const bool has_next = S.get(ui + 1, nxt);
    const char* nA = has_next ? nxt.a : cA; const char* nB = has_next ? nxt.b : cB;
#pragma unroll 1
    for (int t = 0; t < nt; t += 2) {
      const bool last = (t == nt - 2);
      const char* a1 = cA + (size_t)(t + 1) * kstep;
      const char* a2 = last ? nA : cA + (size_t)(t + 2) * kstep; const char* b2 = last ? nB : cB + (size_t)(t + 2) * kstep;
      const char* a3 = a2 + kstep; const char* b3 = b2 + kstep;
#if G_SP2
      GLDB(B0, 0, 0); GLDB(B1, 0, 1); GSCHED; GLDA(At, 0, 0); GSTAGE(GSA(1, 1), a1 + hstepA, voffA);
      GWAIT_V(8); GWAIT_L(0); GBAR; GMMA(0, 0, At, B0); GMMA(0, 1, At, B1); GBAR; GSCHED;
      GLDA(At, 0, 1); GSTAGE(GSB(0, 0), b2, voffB); GSTAGE(GSB(0, 1), b2 + hstepB, voffB); GSTAGE(GSA(0, 0), a2, voffA);
      GWAIT_V(8); GWAIT_L(0); GBAR; GMMA(1, 0, At, B0); GMMA(1, 1, At, B1); GBAR; GSCHED;
      GLDB(B0, 1, 0); GLDB(B1, 1, 1); GSCHED; GLDA(At, 1, 0); GSTAGE(GSA(0, 1), a2 + hstepA, voffA);
      GWAIT_V(8); GWAIT_L(0); GBAR; GMMA(0, 0, At, B0); GMMA(0, 1, At, B1); GBAR; GSCHED;
      GLDA(At, 1, 1); GSTAGE(GSB(1, 0), b3, voffB); GSTAGE(GSB(1, 1), b3 + hstepB, voffB); GSTAGE(GSA(1, 0), a3, voffA);
      GWAIT_V(8); GWAIT_L(0); GBAR; GMMA(1, 0, At, B0); GMMA(1, 1, At, B1); GBAR; GSCHED;
#else
      GLDB(B0, 0, 0); GSCHED; GLDA(At, 0, 0); GSTAGE(GSA(1, 1), a1 + hstepA, voffA);
      GWAIT_L(8); GBAR; GWAIT_L(0); GMMA(0, 0, At, B0); GBAR; GSCHED;
      GLDB(B1, 0, 1); GSTAGE(GSB(0, 0), b2, voffB);
      GBAR; GWAIT_L(0); GMMA(0, 1, At, B1); GBAR;
      GLDA(At, 0, 1); GSTAGE(GSA(0, 0), a2, voffA);
      GBAR; GWAIT_L(0); GMMA(1, 0, At, B0); GBAR; GSCHED;
      GSTAGE(GSB(0, 1), b2 + hstepB, voffB);
      GWAIT_V(6); GBAR; GMMA(1, 1, At, B1); GBAR;
      GLDB(B0, 1, 0); GSCHED; GLDA(At, 1, 0); GSTAGE(GSA(0, 1), a2 + hstepA, voffA);
      GWAIT_L(8); GBAR; GWAIT_L(0); GMMA(0, 0, At, B0); GBAR; GSCHED;
      GLDB(B1, 1, 1); GSTAGE(GSB(1, 0), b3, voffB);
      GBAR; GWAIT_L(0); GMMA(0, 1, At, B1); GBAR;
      GLDA(At, 1, 1); GSTAGE(GSA(1, 0), a3, voffA);
      GBAR; GWAIT_L(0); GMMA(1, 0, At, B0); GBAR; GSCHED;
      GSTAGE(GSB(1, 1), b3 + hstepB, voffB);
      GWAIT_V(6); GBAR; GMMA(1, 1, At, B1); GBAR;
#endif
    }
#ifndef G_ALIGN
#define G_ALIGN 1
#endif
    if (G_ALIGN) { if (wr == 0) GBAR; }
    epi_regs<MS>(P, cur, acc, wr, wc, fr, fq);
    if (!has_next) break;
#pragma unroll
    for (int a = 0; a < 2; ++a)
#pragma unroll
      for (int b = 0; b < 2; ++b)
#pragma unroll
        for (int m = 0; m < 4; ++m)
#pragma unroll
          for (int n = 0; n < 2; ++n) acc[a][b][m][n] = (f32x4){0.f, 0.f, 0.f, 0.f};
    cur = nxt; cA = nA; cB = nB; ++ui;
    if (G_ALIGN) { if (wr == 1) GBAR; }
  }
  GWAIT_V(0);
  if (!G_ALIGN) { if (wr == 0) GBAR; }
  GBAR;
}

DI bool tile_order(int L, int nM, int nN, int& pm, int& pn) {
  const int nwg = nM * nN; if (L >= nwg) return false;
  int wgid = L; { const int q = nwg / 8, r = nwg % 8, xcd = wgid % 8, off = wgid / 8; wgid = (xcd < r ? xcd * (q + 1) : r * (q + 1) + (xcd - r) * q) + off; }
  const int nig = 8 * nN, gid = wgid / nig, fm = gid * 8, gsz = (nM - fm) < 8 ? (nM - fm) : 8;
  pm = fm + ((wgid % nig) % gsz); pn = (wgid % nig) / gsz; return true;
}

DI void transpose_w(const float* __restrict__ src, bf16_t* __restrict__ dst, int K, int N, int gtid, int gthreads) {
  const int total = (K / 8) * N;
  for (int idx = gtid; idx < total; idx += gthreads) {
    const int n = idx % N, k0 = (idx / N) * 8;
    float f[8];
#pragma unroll
    for (int j = 0; j < 8; ++j) f[j] = src[(size_t)(k0 + j) * N + n];
    u32x4 w; w.x = pk_bf16(f[0], f[1]); w.y = pk_bf16(f[2], f[3]); w.z = pk_bf16(f[4], f[5]); w.w = pk_bf16(f[6], f[7]);
    *(u32x4*)(dst + (size_t)n * K + k0) = w;
  }
}
__device__ void phase0(const Params& P, int bid, int nb) {
  const int tid = threadIdx.x, lane = tid & 63, wid = tid >> 6;
  const int gtid = bid * NTHR + tid, gthreads = nb * NTHR;
  transpose_w(P.w_in, P.WtIn, 1024, 3072, gtid, gthreads);
  transpose_w(P.glu_w, P.WtGlu, 512, 512, gtid, gthreads);
  transpose_w(P.w_out, P.WtOut, 1024, 1024, gtid, gthreads);
  transpose_w(P.wp, P.WtP, 256, 1024, gtid, gthreads);
  transpose_w(P.wg, P.WtG, 1024, 1024, gtid, gthreads);
  for (int idx = gtid; idx < NTOK * 8; idx += gthreads) {
    const int tok = idx >> 3, i = idx & 7;
    const float invf = exp2f(-(float)i * 0.125f * 18.931568569324174f);
    const float ang = (float)P.pos[tok] * invf;
    double t = (double)ang * 0.15915494309189535; t -= floor(t);
    const float tf = (float)t;
    P.rope[(size_t)idx * 2] = __builtin_amdgcn_cosf(tf); P.rope[(size_t)idx * 2 + 1] = __builtin_amdgcn_sinf(tf);
  }
  for (int idx0 = gtid; idx0 < NTOK * 256 / 8; idx0 += gthreads * 4) {
    f32x4 a[4], b[4];
#pragma unroll
    for (int u = 0; u < 4; ++u) { const int idx = idx0 + u * gthreads; if (idx < NTOK * 256 / 8) { a[u] = *(const f32x4*)(P.p + (size_t)idx * 8); b[u] = *(const f32x4*)(P.p + (size_t)idx * 8 + 4); } }
#pragma unroll
    for (int u = 0; u < 4; ++u) { const int idx = idx0 + u * gthreads; if (idx < NTOK * 256 / 8) {
      u32x4 w; w.x = pk_bf16(a[u][0], a[u][1]); w.y = pk_bf16(a[u][2], a[u][3]); w.z = pk_bf16(b[u][0], b[u][1]); w.w = pk_bf16(b[u][2], b[u][3]);
      *(u32x4*)(P.Pb + (size_t)idx * 8) = w; } }
  }
  for (int row = (bid * 8 + wid) * 4; row < NTOK; row += nb * 32) {
    f32x4 v[4][4]; float ss[4] = {0.f, 0.f, 0.f, 0.f};
#pragma unroll
    for (int rr = 0; rr < 4; ++rr)
#pragma unroll
      for (int i = 0; i < 4; ++i) v[rr][i] = *(const f32x4*)(P.x + (size_t)(row + rr) * 1024 + i * 256 + lane * 4);
#pragma unroll
    for (int rr = 0; rr < 4; ++rr)
#pragma unroll
      for (int i = 0; i < 4; ++i) ss[rr] += v[rr][i][0] * v[rr][i][0] + v[rr][i][1] * v[rr][i][1] + v[rr][i][2] * v[rr][i][2] + v[rr][i][3] * v[rr][i][3];
#pragma unroll
    for (int o = 1; o < 64; o <<= 1) {
#pragma unroll
      for (int rr = 0; rr < 4; ++rr) ss[rr] += __shfl_xor(ss[rr], o);
    }
#pragma unroll
    for (int rr = 0; rr < 4; ++rr) {
      const float rs = rsqrtf(ss[rr] * (1.0f / 1024.0f) + 1e-6f);
#pragma unroll
      for (int i = 0; i < 4; ++i) {
        const f32x4 w = *(const f32x4*)(P.norm_w + i * 256 + lane * 4);
        u32x2 o; o.x = pk_bf16(v[rr][i][0] * rs * w[0], v[rr][i][1] * rs * w[1]); o.y = pk_bf16(v[rr][i][2] * rs * w[2], v[rr][i][3] * rs * w[3]);
        *(u32x2*)(P.Hb + (size_t)(row + rr) * 1024 + i * 256 + lane * 4) = o;
      }
    }
  }
}

struct SrcIn { const Params* P; int bid, nb;
  DI bool get(int ui, GUnit& u) const {
    int pm, pn; if (!tile_order(ui * nb + bid, 128, 12, pm, pn)) return false;
    const bool isv = (pn == 8 || pn == 9);
    u.a = (const char*)(isv ? (P->WtIn + (size_t)(2048 + (pn - 8) * 256) * 1024) : (P->Hb + (size_t)pm * 256 * 1024));
    u.b = (const char*)(isv ? (P->Hb + (size_t)pm * 256 * 1024) : (P->WtIn + (size_t)pn * 256 * 1024));
    u.rowbase = isv ? (pn - 8) * 256 : pm * 256; u.colbase = isv ? pm * 256 : pn * 256;
    u.mode = (pn < 2) ? 0 : (pn < 4) ? 1 : (pn < 6) ? 2 : (pn < 8) ? 3 : isv ? 4 : 5; return true; } };
struct SrcPle { const Params* P; int bid, nb;
  DI bool get(int ui, GUnit& u) const {
    int pm, pn; if (!tile_order(ui * nb + bid, 128, 4, pm, pn)) return false;
    u.a = (const char*)(P->Pb + (size_t)pm * 256 * 256); u.b = (const char*)(P->WtP + (size_t)pn * 256 * 256); u.rowbase = pm * 256; u.colbase = pn * 256; u.mode = 6; return true; } };
struct SrcN1024 { const bf16_t* A; const bf16_t* B; int mode, bid, nb;
  DI bool get(int ui, GUnit& u) const {
    int pm, pn; if (!tile_order(ui * nb + bid, 128, 4, pm, pn)) return false;
    u.a = (const char*)(A + (size_t)pm * 256 * 1024); u.b = (const char*)(B + (size_t)pn * 256 * 1024); u.rowbase = pm * 256; u.colbase = pn * 256; u.mode = mode; return true; } };
struct SrcGlu { const Params* P; int bid, nb;
  DI bool get(int ui, GUnit& u) const {
    int pm, pn; if (!tile_order(ui * nb + bid, 128, 2, pm, pn)) return false;
    u.a = (const char*)(P->Yg + (size_t)pm * 256 * 512); u.b = (const char*)(P->WtGlu + (size_t)pn * 256 * 512); u.rowbase = pm * 256; u.colbase = pn * 256; u.mode = 7; return true; } };
__device__ void phase1(const Params& P, int bid, int nb) { SrcIn s{&P, bid, nb}; gemm_stream<1024, 3>(P, s); }

__device__ void phase_ssm_naive(const Params& P, int bid, int nb) {
  extern __shared__ __attribute__((aligned(16))) float smf[];
  float* cre = smf;
  float* cim = smf + 1024;
  float* xs = smf + 2048;
  float* us = smf + 4096;
  const int tid = threadIdx.x;
  for (int item = bid; item < 256; item += nb) {
    const int b = item >> 5, g = item & 31;
    __syncthreads();
    for (int i = tid; i < 1024; i += NTHR) { cre[i] = P.c_re[g * 1024 + i]; cim[i] = P.c_im[g * 1024 + i]; }
    float ar = 0.f, ai = 0.f, bbr[16], bbi[16], xr = 0.f, xi = 0.f;
    if (tid < 64) {
      const int n = tid;
      const float lr = P.lam_re[g * 64 + n], li = P.lam_im[g * 64 + n], dt = __expf(P.log_dt[g]);
      const float mag = __expf(lr * dt);
      double tt = (double)(li * dt) * 0.15915494309189535; tt -= floor(tt);
      ar = mag * __builtin_amdgcn_cosf((float)tt); ai = mag * __builtin_amdgcn_sinf((float)tt);
      const float nr = ar - 1.0f, ni = ai, den = lr * lr + li * li;
      const float cr = (nr * lr + ni * li) / den, ci = (ni * lr - nr * li) / den;
#pragma unroll
      for (int q = 0; q < 16; ++q) { const float br = P.b_re[(g * 64 + n) * 16 + q], bi = P.b_im[(g * 64 + n) * 16 + q]; bbr[q] = cr * br - ci * bi; bbi[q] = cr * bi + ci * br; }
    }
    for (int t0 = 0; t0 < SEQ; t0 += 16) {
      __syncthreads();
      if (tid < 256) us[tid] = bf2f(P.U[(size_t)(b * SEQ + t0 + (tid >> 4)) * 512 + g * 16 + (tid & 15)]);
      __syncthreads();
      if (tid < 64) {
#pragma unroll 1
        for (int tau = 0; tau < 16; ++tau) {
          float br = 0.f, bi = 0.f;
#pragma unroll
          for (int q = 0; q < 16; ++q) { const float u = us[tau * 16 + q]; br += bbr[q] * u; bi += bbi[q] * u; }
          const float nxr = ar * xr - ai * xi + br, nxi = ar * xi + ai * xr + bi; xr = nxr; xi = nxi;
          xs[(tau * 64 + tid) * 2] = xr; xs[(tau * 64 + tid) * 2 + 1] = xi;
        }
      }
      __syncthreads();
      if (tid < 256) {
        const int tau = tid >> 4, pch = tid & 15; float y = 0.f;
        for (int n = 0; n < 64; ++n) y += cre[pch * 64 + n] * xs[(tau * 64 + n) * 2] - cim[pch * 64 + n] * xs[(tau * 64 + n) * 2 + 1];
        y += P.ssm_d[g * 16 + pch] * us[tid];
        y = gelu_tanh(y);
        P.Yg[(size_t)(b * SEQ + t0 + tau) * 512 + g * 16 + pch] = (bf16_t)(pk_bf16(y, 0.f) & 0xffffu);
      }
    }
  }
  __syncthreads();
}

__device__ void phase_attn_naive(const Params& P, int bid, int nb) {
  extern __shared__ __attribute__((aligned(16))) float smf[];
  const int tid = threadIdx.x, lane = tid & 63, wid = tid >> 6;
  float* pl = smf + wid * 4224;
  float* qs = pl + 4096;
  float mq = 0.f, mk = 0.f, s1 = 0.f, s2 = 0.f;
  { const float a = fabsf(P.qnw[lane]), b = fabsf(P.knw[lane]); mq = a; mk = b; s1 = P.lq1[lane] * P.lk1[lane]; s2 = P.lq2[lane] * P.lk2[lane];
#pragma unroll
    for (int o = 1; o < 64; o <<= 1) { mq = fmaxf(mq, __shfl_xor(mq, o)); mk = fmaxf(mk, __shfl_xor(mk, o)); s1 += __shfl_xor(s1, o); s2 += __shfl_xor(s2, o); } }
  const float lam = __expf(s1) - __expf(s2) + 0.2f;
  const float mb = 8.0f * mq * mk * LOG2E;
  for (int item = bid * 8 + wid; item < 8 * 4 * SEQ; item += nb * 8) {
    const int i = item & 4095, h = (item >> 12) & 3, b = item >> 14;
    const size_t tok = (size_t)b * SEQ + i;
    float o[2][2], l[2];
#pragma unroll
    for (int c = 0; c < 2; ++c) {
      asm volatile("s_waitcnt lgkmcnt(0)" ::: "memory");
      qs[lane] = bf2f(P.Qb[tok * 512 + h * 128 + c * 64 + lane]);
      asm volatile("s_waitcnt lgkmcnt(0)" ::: "memory");
      float ls = 0.f;
      for (int k0 = 0; k0 <= i; k0 += 64) {
        const int key = k0 + lane; float pv = 0.f;
        if (key <= i) {
          const bf16_t* kr = P.Kb + ((size_t)b * SEQ + key) * 512 + h * 128 + c * 64; float s = 0.f;
#pragma unroll
          for (int d8 = 0; d8 < 8; ++d8) { const u32x4 kw = *(const u32x4*)(kr + d8 * 8); const f32x4 qa = *(const f32x4*)(qs + d8 * 8), qb = *(const f32x4*)(qs + d8 * 8 + 4);
            s += bflo(kw.x) * qa[0] + bfhi(kw.x) * qa[1] + bflo(kw.y) * qa[2] + bfhi(kw.y) * qa[3] + bflo(kw.z) * qb[0] + bfhi(kw.z) * qb[1] + bflo(kw.w) * qb[2] + bfhi(kw.w) * qb[3]; }
          pv = exp2f(s - mb);
        }
        pl[key] = pv; ls += pv;
      }
#pragma unroll
      for (int of = 1; of < 64; of <<= 1) ls += __shfl_xor(ls, of);
      l[c] = ls;
      asm volatile("s_waitcnt lgkmcnt(0)" ::: "memory");
      const int nk = ((i >> 6) + 1) * 64;
      float o0 = 0.f, o1 = 0.f;
      const bf16_t* v0 = P.Vt + ((size_t)(b * 512 + h * 128 + lane)) * 4096; const bf16_t* v1 = v0 + (size_t)64 * 4096;
      for (int k = 0; k < nk; k += 8) {
        const u32x4 a = *(const u32x4*)(v0 + k), bb = *(const u32x4*)(v1 + k); const f32x4 pa = *(const f32x4*)(pl + k), pb = *(const f32x4*)(pl + k + 4);
        o0 += bflo(a.x) * pa[0] + bfhi(a.x) * pa[1] + bflo(a.y) * pa[2] + bfhi(a.y) * pa[3] + bflo(a.z) * pb[0] + bfhi(a.z) * pb[1] + bflo(a.w) * pb[2] + bfhi(a.w) * pb[3];
        o1 += bflo(bb.x) * pa[0] + bfhi(bb.x) * pa[1] + bflo(bb.y) * pa[2] + bfhi(bb.y) * pa[3] + bflo(bb.z) * pb[0] + bfhi(bb.z) * pb[1] + bflo(bb.w) * pb[2] + bfhi(bb.w) * pb[3];
      }
      o[c][0] = o0; o[c][1] = o1;
    }
    const float r0 = o[0][0] / l[0] - lam * o[1][0] / l[1], r1 = o[0][1] / l[0] - lam * o[1][1] / l[1];
    float ss = r0 * r0 + r1 * r1;
#pragma unroll
    for (int of = 1; of < 64; of <<= 1) ss += __shfl_xor(ss, of);
    const float rs = rsqrtf(ss * (1.0f / 128.0f) + 1e-6f) * 0.8f;
    const float y0 = r0 * rs * P.subln_w[lane] * bf2f(P.Za[tok * 512 + h * 128 + lane]);
    const float y1 = r1 * rs * P.subln_w[lane + 64] * bf2f(P.Za[tok * 512 + h * 128 + 64 + lane]);
    P.Ycat[tok * 1024 + 512 + h * 128 + lane] = (bf16_t)(pk_bf16(y0, 0.f) & 0xffffu);
    P.Ycat[tok * 1024 + 512 + h * 128 + 64 + lane] = (bf16_t)(pk_bf16(y1, 0.f) & 0xffffu);
  }
  __syncthreads();
}

__device__ void phase_ssm(const Params& P, int bid, int nb) {
  extern __shared__ __attribute__((aligned(16))) unsigned char sm[];
  constexpr int XP = 288;
  int tid = threadIdx.x; asm volatile("" : "+v"(tid));
  const int lane = tid & 63, wid = __builtin_amdgcn_readfirstlane(tid >> 6), r = lane & 31, hl = lane >> 5;
  float* E = (float*)sm;
  unsigned char* xw = sm + 16384 + wid * (32 * XP);
  const int hs_r = (r >> 2) & 1, tau_r = (r & 3) + 4 * (r >> 3);
  const int pch = lane & 15, kq = lane >> 4;
  for (int item = bid; item < 256; item += nb) {
    const int b = item >> 5, g = item & 31;
    __syncthreads();
    float ar[2], ai[2], a256r[2], a256i[2];
    bf16x8 Bre[2], Bim[2], Cf[4];
    {
      const float dt = __expf(P.log_dt[g]);
#pragma unroll
      for (int sh = 0; sh < 2; ++sh) {
        const int n = r + 32 * sh;
        const float lr = P.lam_re[g * 64 + n], li = P.lam_im[g * 64 + n];
        const float mag = __expf(lr * dt);
        double tt = (double)(li * dt) * 0.15915494309189535; tt -= floor(tt);
        ar[sh] = mag * __builtin_amdgcn_cosf((float)tt); ai[sh] = mag * __builtin_amdgcn_sinf((float)tt);
        const float nr = ar[sh] - 1.0f, ni = ai[sh], den = lr * lr + li * li;
        const float cr = (nr * lr + ni * li) / den, ci = (ni * lr - nr * li) / den;
        const f32x4 br0 = *(const f32x4*)(P.b_re + (g * 64 + n) * 16 + 8 * hl), br1 = *(const f32x4*)(P.b_re + (g * 64 + n) * 16 + 8 * hl + 4);
        const f32x4 bi0 = *(const f32x4*)(P.b_im + (g * 64 + n) * 16 + 8 * hl), bi1 = *(const f32x4*)(P.b_im + (g * 64 + n) * 16 + 8 * hl + 4);
        u32x4 wr_, wi_;
        wr_.x = pk_bf16(cr * br0[0] - ci * bi0[0], cr * br0[1] - ci * bi0[1]); wr_.y = pk_bf16(cr * br0[2] - ci * bi0[2], cr * br0[3] - ci * bi0[3]);
        wr_.z = pk_bf16(cr * br1[0] - ci * bi1[0], cr * br1[1] - ci * bi1[1]); wr_.w = pk_bf16(cr * br1[2] - ci * bi1[2], cr * br1[3] - ci * bi1[3]);
        wi_.x = pk_bf16(cr * bi0[0] + ci * br0[0], cr * bi0[1] + ci * br0[1]); wi_.y = pk_bf16(cr * bi0[2] + ci * br0[2], cr * bi0[3] + ci * br0[3]);
        wi_.z = pk_bf16(cr * bi1[0] + ci * br1[0], cr * bi1[1] + ci * br1[1]); wi_.w = pk_bf16(cr * bi1[2] + ci * br1[2], cr * bi1[3] + ci * br1[3]);
        Bre[sh] = __builtin_bit_cast(bf16x8, wr_); Bim[sh] = __builtin_bit_cast(bf16x8, wi_);
        float pr = ar[sh], pi = ai[sh];
#pragma unroll
        for (int q = 0; q < 7; ++q) { const float t = pr * pr - pi * pi; pi = 2.0f * pr * pi; pr = t; }
        a256r[sh] = pr; a256i[sh] = pi;
      }
#pragma unroll
      for (int ks = 0; ks < 4; ++ks) {
        const int n0 = 16 * ks + 4 * kq;
        const f32x4 cre = *(const f32x4*)(P.c_re + (g * 16 + pch) * 64 + n0), cim = *(const f32x4*)(P.c_im + (g * 16 + pch) * 64 + n0);
        u32x4 w; w.x = pk_bf16(cre[0], -cim[0]); w.y = pk_bf16(cre[1], -cim[1]); w.z = pk_bf16(cre[2], -cim[2]); w.w = pk_bf16(cre[3], -cim[3]);
        Cf[ks] = __builtin_bit_cast(bf16x8, w);
      }
    }
    bf16x8 Df;
    { const float dsk = P.ssm_d[g * 16 + pch]; u32x4 w = {0u, 0u, 0u, 0u};
      if (kq < 2) { const int jj = pch - 8 * kq; const unsigned hv = pk_bf16(dsk, 0.f) & 0xffffu;
        if (jj >= 0 && jj < 8) { const unsigned val = (jj & 1) ? (hv << 16) : hv; if ((jj >> 1) == 0) w.x = val; else if ((jj >> 1) == 1) w.y = val; else if ((jj >> 1) == 2) w.z = val; else w.w = val; } }
      Df = __builtin_bit_cast(bf16x8, w); }
    const unsigned uaoff = (unsigned)((kq < 2) ? (256 + 16 * kq) : (16 * (kq - 2)));
    const char* ub = (const char*)(P.U + ((size_t)b * SEQ + 512 * wid) * 512 + g * 16);
    char* yb = (char*)(P.Yg + ((size_t)b * SEQ + 512 * wid) * 512 + g * 16);
    const unsigned aoff = (unsigned)(((128 * (2 * hs_r + (tau_r & 1)) + (tau_r >> 1)) * 512 + 8 * hl) * 2);
    typedef float f32x2v __attribute__((ext_vector_type(2)));
    f32x2v xr[2] = {{0.f, 0.f}, {0.f, 0.f}}, xi[2] = {{0.f, 0.f}, {0.f, 0.f}};
    f32x16 z16;
#pragma unroll
    for (int i = 0; i < 16; ++i) z16[i] = 0.f;
    bf16x8 afr[16];
#pragma unroll
    for (int t = 0; t < 16; ++t) afr[t] = *(const bf16x8*)(ub + aoff + (unsigned)(t * 8 * 512 * 2));
#pragma unroll
    for (int t = 0; t < 16; ++t) {
#pragma unroll
      for (int sh = 0; sh < 2; ++sh) {
        const f32x16 bur = __builtin_amdgcn_mfma_f32_32x32x16_bf16(afr[t], Bre[sh], z16, 0, 0, 0);
        const f32x16 bui = __builtin_amdgcn_mfma_f32_32x32x16_bf16(afr[t], Bim[sh], z16, 0, 0, 0);
#pragma unroll
        for (int j = 0; j < 8; ++j) { const f32x2v br2 = {bur[2 * j], bur[2 * j + 1]}, bi2 = {bui[2 * j], bui[2 * j + 1]};
          const f32x2v nr = ar[sh] * xr[sh] + br2 - ai[sh] * xi[sh], ni = ar[sh] * xi[sh] + bi2 + ai[sh] * xr[sh]; xr[sh] = nr; xi[sh] = ni; }
      }
    }
    const int cidx0 = 4 * wid + 2 * hl;
#pragma unroll
    for (int sh = 0; sh < 2; ++sh) {
      E[(cidx0 * 64 + r + 32 * sh) * 2] = xr[sh].x; E[(cidx0 * 64 + r + 32 * sh) * 2 + 1] = xi[sh].x;
      E[((cidx0 + 1) * 64 + r + 32 * sh) * 2] = xr[sh].y; E[((cidx0 + 1) * 64 + r + 32 * sh) * 2 + 1] = xi[sh].y;
    }
    __syncthreads();
    {
      float sr[2] = {0.f, 0.f}, si[2] = {0.f, 0.f};
#pragma unroll 1
      for (int c2 = 0; c2 < 30; ++c2) {
        if (c2 < cidx0) {
#pragma unroll
          for (int sh = 0; sh < 2; ++sh) {
            const float er = E[(c2 * 64 + r + 32 * sh) * 2], ei = E[(c2 * 64 + r + 32 * sh) * 2 + 1];
            const float nr = a256r[sh] * sr[sh] - a256i[sh] * si[sh] + er, ni = a256r[sh] * si[sh] + a256i[sh] * sr[sh] + ei; sr[sh] = nr; si[sh] = ni;
          }
        }
      }
#pragma unroll
      for (int sh = 0; sh < 2; ++sh) {
        const float e0r = xr[sh].x, e0i = xi[sh].x;
        const float s1r = a256r[sh] * sr[sh] - a256i[sh] * si[sh] + e0r, s1i = a256r[sh] * si[sh] + a256i[sh] * sr[sh] + e0i;
        xr[sh] = (f32x2v){sr[sh], s1r}; xi[sh] = (f32x2v){si[sh], s1i};
      }
    }
    {
      const f32x4 z4 = {0.f, 0.f, 0.f, 0.f};
#pragma unroll
      for (int t = 0; t < 16; ++t) {
        *(bf16x8*)(xw + (hs_r * 16 + tau_r) * XP + 256 + 16 * hl) = afr[t];
#pragma unroll
        for (int sh = 0; sh < 2; ++sh) {
          const f32x16 bur = __builtin_amdgcn_mfma_f32_32x32x16_bf16(afr[t], Bre[sh], z16, 0, 0, 0);
          const f32x16 bui = __builtin_amdgcn_mfma_f32_32x32x16_bf16(afr[t], Bim[sh], z16, 0, 0, 0);
#pragma unroll
          for (int j = 0; j < 8; ++j) {
            const f32x2v br2 = {bur[2 * j], bur[2 * j + 1]}, bi2 = {bui[2 * j], bui[2 * j + 1]};
            const f32x2v nr = ar[sh] * xr[sh] + br2 - ai[sh] * xi[sh], ni = ar[sh] * xi[sh] + bi2 + ai[sh] * xr[sh]; xr[sh] = nr; xi[sh] = ni;
            *(unsigned*)(xw + (hl * 16 + 2 * j) * XP + (r + 32 * sh) * 4) = pk_bf16(nr.x, ni.x);
            *(unsigned*)(xw + (hl * 16 + 2 * j + 1) * XP + (r + 32 * sh) * 4) = pk_bf16(nr.y, ni.y);
          }
        }
        asm volatile("s_waitcnt lgkmcnt(0)" ::: "memory");
#pragma unroll
        for (int mt = 0; mt < 2; ++mt) {
          f32x4 acc = z4;
#pragma unroll
          for (int ks = 0; ks < 4; ++ks) {
            const bf16x8 xa = *(const bf16x8*)(xw + (mt * 16 + pch) * XP + (32 * ks + 8 * kq) * 2);
            acc = __builtin_amdgcn_mfma_f32_16x16x32_bf16(xa, Cf[ks], acc, 0, 0, 0);
          }
          { const bf16x8 ua = *(const bf16x8*)(xw + (mt * 16 + pch) * XP + uaoff);
            acc = __builtin_amdgcn_mfma_f32_16x16x32_bf16(ua, Df, acc, 0, 0, 0); }
#pragma unroll
          for (int i = 0; i < 4; ++i) {
            const float y = gelu_tanh(acc[i]);
            *(bf16_t*)(yb + (unsigned)(((128 * (2 * mt + ((4 * kq + i) & 1)) + 8 * t + ((4 * kq + i) >> 1)) * 512 + pch) * 2)) = (bf16_t)(pk_bf16(y, 0.f) & 0xffffu);
          }
        }
        asm volatile("s_waitcnt lgkmcnt(0)" ::: "memory");
      }
    }
  }
  __syncthreads();
}

DI int pi_row(int r) { const int hh = (r >> 2) & 1, i = (r & 3) + 4 * (r >> 3); return 16 * (i >> 3) + 8 * hh + (i & 7); }
DI int crow16(int i, int hh) { return (i & 3) + 8 * (i >> 2) + 4 * hh; }
__device__ void phase_attn(const Params& P, int bid, int nb) {
  extern __shared__ __attribute__((aligned(16))) unsigned char sm[];
  constexpr int KP = 272, VP = 272, KBYTES = 128 * KP, VBYTES = 128 * VP, BUF = KBYTES + VBYTES, YOFF = BUF, YP = 272;
  int tid = threadIdx.x; asm volatile("" : "+v"(tid));
  const int lane = tid & 63, wid = __builtin_amdgcn_readfirstlane(tid >> 6), c = wid >> 2, qs = wid & 3, r = lane & 31, hl = lane >> 5;
  float mq, mk, s1, s2;
  { mq = fabsf(P.qnw[lane]); mk = fabsf(P.knw[lane]); s1 = P.lq1[lane] * P.lk1[lane]; s2 = P.lq2[lane] * P.lk2[lane];
#pragma unroll
    for (int o = 1; o < 64; o <<= 1) { mq = fmaxf(mq, __shfl_xor(mq, o)); mk = fmaxf(mk, __shfl_xor(mk, o)); s1 += __shfl_xor(s1, o); s2 += __shfl_xor(s2, o); } }
  const float lam = __expf(s1) - __expf(s2) + 0.2f;
  const float nmb = -8.0f * mq * mk * LOG2E;
  const int pir = pi_row(r);
  const int vb = (nb % 8 == 0) ? (bid % 8) * (nb / 8) + bid / 8 : bid;
  for (int pid = vb; pid < 512; pid += nb) {
    const int bh = pid >> 4, kk = pid & 15, b = bh >> 2, h = bh & 3;
#pragma unroll 1
    for (int half = 0; half < 2; ++half) {
      const int qb = half ? kk : 31 - kk, q0 = qb * 128, qw0 = q0 + 32 * qs;
      const size_t tok0 = (size_t)b * SEQ;
      bf16x8 qf[4];
#pragma unroll
      for (int ks = 0; ks < 4; ++ks) qf[ks] = *(const bf16x8*)((const char*)(P.Qb + (tok0 + qw0) * 512 + h * 128 + c * 64) + (unsigned)((r * 512 + ks * 16 + hl * 8) * 2));
      const bf16_t* kg = P.Kb + tok0 * 512 + h * 128;
      const bf16_t* vg = P.Vt + ((size_t)(b * 512 + h * 128)) * 4096;
      u32x4 st[8];
      int t3 = tid; asm volatile("" : "+v"(t3));
      const unsigned koff = (unsigned)((t3 >> 4) * 512 + (t3 & 15) * 8) * 2u, voff_ = (unsigned)((t3 >> 4) * 4096 + (t3 & 15) * 8) * 2u;
      const unsigned klds = (unsigned)((t3 >> 4) * KP + (t3 & 15) * 16), vlds = (unsigned)(KBYTES + (t3 >> 4) * VP + (t3 & 15) * 16);
      const int nst = qb + 1;
#pragma unroll
      for (int i = 0; i < 4; ++i) { st[i] = *(const u32x4*)((const char*)kg + koff + (unsigned)(i * 32 * 1024)); st[4 + i] = *(const u32x4*)((const char*)vg + voff_ + (unsigned)(i * 32 * 8192)); }
#pragma unroll
      for (int i = 0; i < 4; ++i) { *(u32x4*)(sm + klds + i * 32 * KP) = st[i]; *(u32x4*)(sm + vlds + i * 32 * VP) = st[4 + i]; }
      __syncthreads();
      f32x16 o[4];
#pragma unroll
      for (int dt = 0; dt < 4; ++dt)
#pragma unroll
        for (int i = 0; i < 16; ++i) o[dt][i] = 0.f;
      float l = 0.f;
#pragma unroll 1
      for (int stp = 0; stp < nst; ++stp) {
        const bool more = (stp + 1 < nst);
        if (more) {
#pragma unroll
          for (int i = 0; i < 4; ++i) { st[i] = *(const u32x4*)((const char*)kg + (size_t)(stp + 1) * (128 * 1024) + koff + (unsigned)(i * 32 * 1024)); st[4 + i] = *(const u32x4*)((const char*)vg + (size_t)(stp + 1) * 256 + voff_ + (unsigned)(i * 32 * 8192)); }
        }
        const unsigned char* bbuf = sm + (stp & 1) * BUF;
#pragma unroll
        for (int sub = 0; sub < 2; ++sub) {
        const int kt = 2 * stp + sub;
        if (64 * kt <= qw0 + 31) {
          const unsigned char* kbuf = bbuf + sub * 64 * KP; const unsigned char* vbuf = bbuf + KBYTES + sub * 128;
          f32x16 s[2];
#pragma unroll
          for (int i = 0; i < 16; ++i) { s[0][i] = nmb; s[1][i] = nmb; }
          __builtin_amdgcn_s_setprio(1);
#pragma unroll
          for (int ks = 0; ks < 4; ++ks) {
            const bf16x8 k0 = *(const bf16x8*)(kbuf + pir * KP + (c * 64 + ks * 16 + hl * 8) * 2);
            const bf16x8 k1 = *(const bf16x8*)(kbuf + (32 + pir) * KP + (c * 64 + ks * 16 + hl * 8) * 2);
            s[0] = __builtin_amdgcn_mfma_f32_32x32x16_bf16(k0, qf[ks], s[0], 0, 0, 0);
            s[1] = __builtin_amdgcn_mfma_f32_32x32x16_bf16(k1, qf[ks], s[1], 0, 0, 0);
          }
          __builtin_amdgcn_s_setprio(0);
          if (64 * kt + 63 > qw0) {
            asm volatile("" ::: "memory");
#pragma unroll
            for (int mt = 0; mt < 2; ++mt)
#pragma unroll
              for (int i = 0; i < 16; ++i) { const int key = 64 * kt + 32 * mt + 16 * (i >> 3) + 8 * hl + (i & 7); s[mt][i] = (key <= qw0 + r) ? s[mt][i] : -1.0e30f; }
            asm volatile("" ::: "memory");
          }
          bf16x8 pb[2][2];
#pragma unroll
          for (int mt = 0; mt < 2; ++mt) {
            float pv[16];
#pragma unroll
            for (int i = 0; i < 16; ++i) { const float e = __builtin_amdgcn_exp2f(s[mt][i]); pv[i] = e; l += e; }
#pragma unroll
            for (int sp = 0; sp < 2; ++sp) {
              u32x4 w; w.x = pk_bf16(pv[8 * sp], pv[8 * sp + 1]); w.y = pk_bf16(pv[8 * sp + 2], pv[8 * sp + 3]); w.z = pk_bf16(pv[8 * sp + 4], pv[8 * sp + 5]); w.w = pk_bf16(pv[8 * sp + 6], pv[8 * sp + 7]);
              pb[mt][sp] = __builtin_bit_cast(bf16x8, w);
            }
          }
          {
            bf16x8 vc[4], vn[4];
#pragma unroll
            for (int dt = 0; dt < 4; ++dt) vc[dt] = *(const bf16x8*)(vbuf + (32 * dt + r) * VP + (8 * hl) * 2);
#pragma unroll
            for (int g = 0; g < 4; ++g) {
              if (g < 3) {
#pragma unroll
                for (int dt = 0; dt < 4; ++dt) vn[dt] = *(const bf16x8*)(vbuf + (32 * dt + r) * VP + (16 * (g + 1) + 8 * hl) * 2);
              }
              __builtin_amdgcn_sched_barrier(0);
              __builtin_amdgcn_s_setprio(1);
#pragma unroll
              for (int dt = 0; dt < 4; ++dt) o[dt] = __builtin_amdgcn_mfma_f32_32x32x16_bf16(vc[dt], pb[g >> 1][g & 1], o[dt], 0, 0, 0);
              __builtin_amdgcn_s_setprio(0);
              __builtin_amdgcn_sched_barrier(0);
              if (g < 3) {
#pragma unroll
                for (int dt = 0; dt < 4; ++dt) vc[dt] = vn[dt];
              }
            }
          }
        }
        }
        if (more) {
          unsigned char* nb_ = sm + ((stp + 1) & 1) * BUF;
#pragma unroll
          for (int i = 0; i < 4; ++i) { *(u32x4*)(nb_ + klds + i * 32 * KP) = st[i]; *(u32x4*)(nb_ + vlds + i * 32 * VP) = st[4 + i]; }
        }
        __syncthreads();
      }
      l += __shfl_xor(l, 32);
      const float inv = 1.0f / l;
      float* oex = (float*)sm;
      float* ssx = (float*)(sm + YOFF + 128 * YP);
      {
#pragma unroll
        for (int dd = 0; dd < 2; ++dd)
#pragma unroll
          for (int i = 0; i < 16; ++i) {
            const float v0 = o[dd][i] * inv, v1 = o[2 + dd][i] * inv;
            oex[((c * 4 + qs) * 64 + 32 * dd + crow16(i, hl)) * 32 + r] = c ? v0 : v1;
          }
      }
      __syncthreads();
      {
        float ss = 0.f;
        float vv[2][16];
#pragma unroll
        for (int dd = 0; dd < 2; ++dd)
#pragma unroll
          for (int i = 0; i < 16; ++i) {
            const float own = (c ? o[2 + dd][i] : o[dd][i]) * inv;
            const float oth = oex[(((1 - c) * 4 + qs) * 64 + 32 * dd + crow16(i, hl)) * 32 + r];
            const float v = c ? (oth - lam * own) : (own - lam * oth);
            vv[dd][i] = v; ss += v * v;
          }
        ss += __shfl_xor(ss, 32);
        if (hl == 0) ssx[c * 128 + 32 * qs + r] = ss;
#pragma unroll
        for (int dd = 0; dd < 2; ++dd)
#pragma unroll
          for (int g = 0; g < 4; ++g) {
            const int dv0 = 64 * c + 32 * dd + 8 * g + 4 * hl;
            const f32x4 wv = *(const f32x4*)(P.subln_w + dv0);
            u32x2 w; w.x = pk_bf16(vv[dd][4 * g] * wv[0], vv[dd][4 * g + 1] * wv[1]); w.y = pk_bf16(vv[dd][4 * g + 2] * wv[2], vv[dd][4 * g + 3] * wv[3]);
            *(u32x2*)(sm + YOFF + (32 * qs + r) * YP + dv0 * 2) = w;
          }
      }
      __syncthreads();
      int t4 = tid; asm volatile("" : "+v"(t4));
      const char* zab = (const char*)(P.Za + (tok0 + q0) * 512 + h * 128);
      char* ycb = (char*)(P.Ycat + (tok0 + q0) * 1024 + 512 + h * 128);
#pragma unroll
      for (int i = 0; i < 4; ++i) {
        const int id = t4 + 512 * i, row = id >> 4, ch = id & 15;
        const u32x4 y8 = *(const u32x4*)(sm + YOFF + row * YP + ch * 16);
        const u32x4 za = *(const u32x4*)(zab + (unsigned)(row * 1024 + ch * 16));
        const float rs = rsqrtf((ssx[row] + ssx[128 + row]) * (1.0f / 128.0f) + 1e-6f) * 0.8f;
        u32x4 w;
        w.x = pk_bf16(bflo(y8.x) * rs * bflo(za.x), bfhi(y8.x) * rs * bfhi(za.x)); w.y = pk_bf16(bflo(y8.y) * rs * bflo(za.y), bfhi(y8.y) * rs * bfhi(za.y));
        w.z = pk_bf16(bflo(y8.z) * rs * bflo(za.z), bfhi(y8.z) * rs * bfhi(za.z)); w.w = pk_bf16(bflo(y8.w) * rs * bflo(za.w), bfhi(y8.w) * rs * bfhi(za.w));
        *(u32x4*)(ycb + (unsigned)(row * 2048 + ch * 16)) = w;
      }
    }
  }
  __syncthreads();
}

__device__ void phase3(const Params& P, int bid, int nb) { SrcGlu s{&P, bid, nb}; gemm_stream<512, 4>(P, s); }
__device__ void phase4(const Params& P, int bid, int nb) {
  const bool ple_first = ((bid >> 3) & 1) != 0;
  SrcPle sp{&P, bid, nb}; SrcN1024 so{P.Ycat, P.WtOut, 8, bid, nb};
  if (ple_first) gemm_stream<256, 1>(P, sp);
  gemm_stream<1024, 8>(P, so);
  if (!ple_first) gemm_stream<256, 1>(P, sp);
}
__device__ void phase5(const Params& P, int bid, int nb) { SrcN1024 s{P.X1b, P.WtG, 9, bid, nb}; gemm_stream<1024, 16>(P, s); }

__global__ void __launch_bounds__(NTHR, 2) mega(Params P, int plo, int phi) {
  const int bid = blockIdx.x, nb = gridDim.x;
#define IN(k) (plo <= (k) && (k) < phi)
  extern __shared__ __attribute__((aligned(16))) unsigned char smk[];
  volatile LAS unsigned* xst = (volatile LAS unsigned*)(smk + LDS_BYTES);
  if (threadIdx.x < 4) xst[threadIdx.x] = 0u;
  __syncthreads();
  XcdBarrier xbar = xcd_barrier_post(P.barw, xst);
  if (plo > 1000) cg::this_grid().sync();
#define SEAM(k) do { if (IN(k) && IN((k) + 1)) xcd_barrier(xbar); } while (0)
#ifndef REP
#define REP -1
#endif
#define GS() xcd_barrier(xbar)
  if (IN(0)) { phase0(P, bid, nb); if (REP == 0) { GS(); phase0(P, bid, nb); } }
  SEAM(0);
  if (IN(1)) { phase1(P, bid, nb); if (REP == 1) { GS(); phase1(P, bid, nb); } }
  SEAM(1);
  if (IN(2)) { phase_ssm(P, bid, nb); if (REP == 2) { GS(); phase_ssm(P, bid, nb); } phase_attn(P, bid, nb); if (REP == 6) { GS(); phase_attn(P, bid, nb); } }
  SEAM(2);
  if (IN(3)) { phase3(P, bid, nb); if (REP == 3) { GS(); phase3(P, bid, nb); } }
  SEAM(3);
  if (IN(4)) { phase4(P, bid, nb); if (REP == 4) { GS(); phase4(P, bid, nb); } }
  SEAM(4);
  if (IN(5)) phase5(P, bid, nb);
  if (REP == 5) { GS(); phase4(P, bid, nb); GS(); phase5(P, bid, nb); }
}

#ifndef N_LAUNCH_MODE
#define N_LAUNCH_MODE 1
#endif

extern "C" void kernel_launch(void* const* d_in, const int* in_sizes, int n_in, void* d_out, int out_size, void* d_ws, size_t ws_size, hipStream_t stream) {
  Params P{};
  P.x = (const float*)d_in[0]; P.p = (const float*)d_in[1]; P.pos = (const int*)d_in[2];
  P.norm_w = (const float*)d_in[3]; P.w_in = (const float*)d_in[4]; P.lam_re = (const float*)d_in[5]; P.lam_im = (const float*)d_in[6];
  P.log_dt = (const float*)d_in[7]; P.b_re = (const float*)d_in[8]; P.b_im = (const float*)d_in[9]; P.c_re = (const float*)d_in[10]; P.c_im = (const float*)d_in[11];
  P.ssm_d = (const float*)d_in[12]; P.glu_w = (const float*)d_in[13]; P.glu_b = (const float*)d_in[14]; P.qnw = (const float*)d_in[15]; P.knw = (const float*)d_in[16];
  P.lq1 = (const float*)d_in[17]; P.lk1 = (const float*)d_in[18]; P.lq2 = (const float*)d_in[19]; P.lk2 = (const float*)d_in[20]; P.subln_w = (const float*)d_in[21];
  P.w_out = (const float*)d_in[22]; P.wp = (const float*)d_in[23]; P.wg = (const float*)d_in[24];
  P.out = (float*)d_out;
  char* w = (char*)d_ws; size_t off = 16384;
  P.barw = (unsigned*)d_ws;
  auto take = [&](size_t bytes) { char* r = w + off; off += (bytes + 255) & ~(size_t)255; return (bf16_t*)r; };
  P.Hb = take((size_t)NTOK * 1024 * 2); P.X1b = P.Hb;
  P.WtIn = take((size_t)3072 * 1024 * 2); P.WtGlu = take((size_t)512 * 512 * 2); P.WtOut = take((size_t)1024 * 1024 * 2);
  P.WtP = take((size_t)1024 * 256 * 2); P.WtG = take((size_t)1024 * 1024 * 2);
  P.Pb = take((size_t)NTOK * 256 * 2);
  P.U = take((size_t)NTOK * 512 * 2); P.Zs = take((size_t)NTOK * 512 * 2); P.Qb = take((size_t)NTOK * 512 * 2); P.Kb = take((size_t)NTOK * 512 * 2);
  P.Vt = take((size_t)NTOK * 512 * 2); P.Za = take((size_t)NTOK * 512 * 2); P.Yg = take((size_t)NTOK * 512 * 2);
  P.Ycat = take((size_t)NTOK * 1024 * 2); P.PP = take((size_t)NTOK * 1024 * 2);
  P.rope = (float*)take((size_t)NTOK * 16 * 4);

  static int grid_blocks = 0;
  if (!grid_blocks) {
    hipFuncSetAttribute((const void*)mega, hipFuncAttributeMaxDynamicSharedMemorySize, LDS_BYTES + 256);
    int dev = 0, cus = 0, per_cu = 0;
    hipGetDevice(&dev);
    hipDeviceGetAttribute(&cus, hipDeviceAttributeMultiprocessorCount, dev);
    hipOccupancyMaxActiveBlocksPerMultiprocessor(&per_cu, mega, NTHR, LDS_BYTES + 256);
    if (per_cu < 1) per_cu = 1;
    grid_blocks = cus;
  }
#if N_LAUNCH_MODE == 1
  hipMemsetAsync(d_ws, 0, 16384, stream);
  int plo = 0, phi = 6;
  void* args[] = {&P, &plo, &phi};
  hipError_t e = hipLaunchCooperativeKernel((void*)mega, dim3(grid_blocks), dim3(NTHR), args, LDS_BYTES + 256, stream);
  if (e != hipSuccess) fprintf(stderr, "cooperative launch failed: %s (grid %d)\n", hipGetErrorString(e), grid_blocks);
#else
  for (int ph = 0; ph < 6; ++ph) hipLaunchKernelGGL(mega, dim3(grid_blocks), dim3(NTHR), LDS_BYTES, stream, P, ph, ph + 1);
#endif
}
```

```cpp
#include <hip/hip_runtime.h>
#include <hip/hip_cooperative_groups.h>
#include <stdint.h>
#include <cstdio>
namespace cg = cooperative_groups;

typedef unsigned short bf16_t;
typedef short bf16x8 __attribute__((ext_vector_type(8)));
typedef float f32x4 __attribute__((ext_vector_type(4)));
typedef float f32x16 __attribute__((ext_vector_type(16)));
typedef unsigned u32x4 __attribute__((ext_vector_type(4)));
typedef unsigned u32x2 __attribute__((ext_vector_type(2)));

#define NTOK 32768
#define SEQ 4096
#define DM 1024
#define INC 3072
#define NTHR 512
#define LDS_BYTES 139264
#define LOG2E 1.4426950408889634f

struct Params {
  const float *x, *p; const int* pos;
  const float *norm_w, *w_in, *lam_re, *lam_im, *log_dt, *b_re, *b_im, *c_re, *c_im, *ssm_d, *glu_w, *glu_b,
      *qnw, *knw, *lq1, *lk1, *lq2, *lk2, *subln_w, *w_out, *wp, *wg;
  float* out;
  float* rope; unsigned* barw;
  bf16_t *Hb, *WtIn, *WtGlu, *WtOut, *WtP, *WtG, *Pb, *U, *Zs, *Qb, *Kb, *Vt, *Za, *Yg, *Ycat, *X1b, *PP;
};

#define DI __device__ __forceinline__
DI unsigned pk_bf16(float lo, float hi) { unsigned r; asm("v_cvt_pk_bf16_f32 %0, %1, %2" : "=v"(r) : "v"(lo), "v"(hi)); return r; }
DI float bflo(unsigned w) { return __uint_as_float(w << 16); }
DI float bfhi(unsigned w) { return __uint_as_float(w & 0xffff0000u); }
DI float bf2f(bf16_t v) { return __uint_as_float(((unsigned)v) << 16); }
DI float sigmoidf_(float v) { return __builtin_amdgcn_rcpf(1.0f + __builtin_amdgcn_exp2f(-LOG2E * v)); }
DI float siluf_(float v) { return v * __builtin_amdgcn_rcpf(1.0f + __builtin_amdgcn_exp2f(-LOG2E * v)); }
DI float gelu_tanh(float v) { float u = 0.7978845608028654f * (v + 0.044715f * v * v * v); return v * __builtin_amdgcn_rcpf(1.0f + __builtin_amdgcn_exp2f(-2.0f * LOG2E * u)); }
DI void store16bf(bf16_t* dst, const f32x4 (&v)[4]) {
  u32x4 a, b;
  a.x = pk_bf16(v[0][0], v[0][1]); a.y = pk_bf16(v[0][2], v[0][3]); a.z = pk_bf16(v[1][0], v[1][1]); a.w = pk_bf16(v[1][2], v[1][3]);
  b.x = pk_bf16(v[2][0], v[2][1]); b.y = pk_bf16(v[2][2], v[2][3]); b.z = pk_bf16(v[3][0], v[3][1]); b.w = pk_bf16(v[3][2], v[3][3]);
  *(u32x4*)dst = a; *(u32x4*)(dst + 8) = b;
}
DI void cvt16bf(const u32x4 a, const u32x4 b, f32x4 (&v)[4]) {
  v[0] = (f32x4){bflo(a.x), bfhi(a.x), bflo(a.y), bfhi(a.y)}; v[1] = (f32x4){bflo(a.z), bfhi(a.z), bflo(a.w), bfhi(a.w)};
  v[2] = (f32x4){bflo(b.x), bfhi(b.x), bflo(b.y), bfhi(b.y)}; v[3] = (f32x4){bflo(b.z), bfhi(b.z), bflo(b.w), bfhi(b.w)};
}
DI void load16bf(const bf16_t* src, f32x4 (&v)[4]) {
  u32x4 a = *(const u32x4*)src, b = *(const u32x4*)(src + 8);
  v[0] = (f32x4){bflo(a.x), bfhi(a.x), bflo(a.y), bfhi(a.y)}; v[1] = (f32x4){bflo(a.z), bfhi(a.z), bflo(a.w), bfhi(a.w)};
  v[2] = (f32x4){bflo(b.x), bfhi(b.x), bflo(b.y), bfhi(b.y)}; v[3] = (f32x4){bflo(b.z), bfhi(b.z), bflo(b.w), bfhi(b.w)};
}

#define XB_TMO      128
#define XB_XCNT(j)  (256  + 64 * (j))
#define XB_XSUB(j)  (1280 + 64 * (j))
#define XB_XGEN(j)  (2304 + 64 * (j))
#define XB_TOP      3328
#define XB_TOPGEN   3392
#define XCD_BAR_WORDS 3456
#define XB_SPIN_CAP (1u << 18)
#define LAS __attribute__((address_space(3)))
DI unsigned xb_ld(unsigned* p) { return __hip_atomic_load(p, __ATOMIC_RELAXED, __HIP_MEMORY_SCOPE_AGENT); }
DI unsigned xb_add(unsigned* p, unsigned v) { return __hip_atomic_fetch_add(p, v, __ATOMIC_RELAXED, __HIP_MEMORY_SCOPE_AGENT); }
DI unsigned xb_xcc_id() { return (unsigned)__builtin_amdgcn_s_getreg((3 << 11) | 20) & 0xFu; }
#define XB_SPIN(cond, bar) do { unsigned _sp = 0; while (cond) { __builtin_amdgcn_s_sleep(1); \
    if ((++_sp & 255u) == 0u) { if (xb_ld(&(bar)[XB_TMO])) break; if (_sp > XB_SPIN_CAP) { atomicAdd(&(bar)[XB_TMO], 1u); break; } } } } while (0)
struct XcdBarrier { unsigned* bar; unsigned x; volatile LAS unsigned* st; };
DI XcdBarrier xcd_barrier_post(unsigned* bar, volatile LAS unsigned* st) {
  XcdBarrier b; b.bar = bar; b.x = xb_xcc_id(); b.st = st;
  if (threadIdx.x == 0) (void)xb_add(&bar[XB_XCNT(b.x)], 1u);
  return b;
}
DI void xcd_barrier_complete(unsigned* bar, unsigned x, unsigned& nloc, unsigned& nx) {
  const unsigned G = gridDim.x * gridDim.y * gridDim.z;
  unsigned sum, cnt, mine, sp = 0u;
  for (;;) {
    sum = 0u; cnt = 0u; mine = 0u;
#pragma unroll
    for (unsigned j = 0; j < 16; ++j) { const unsigned c = xb_ld(&bar[XB_XCNT(j)]); sum += c; cnt += (c > 0u) ? 1u : 0u; mine = (j == x) ? c : mine; }
    if (sum == G) break;
    __builtin_amdgcn_s_sleep(1);
    if ((++sp & 255u) == 0u) { if (xb_ld(&bar[XB_TMO])) break; if (sp > XB_SPIN_CAP) { atomicAdd(&bar[XB_TMO], 1u); break; } }
  }
  nloc = mine > 0u ? mine : 1u; nx = cnt > 0u ? cnt : 1u;
}
DI void xcd_barrier(const XcdBarrier& b) {
  asm volatile("s_waitcnt vmcnt(0)" ::: "memory");
  __syncthreads();
  if (threadIdx.x == 0) {
    unsigned* bar = b.bar;
    __builtin_amdgcn_s_waitcnt(0);
    unsigned nloc = b.st[0], nx = b.st[1];
    if (nloc == 0u) { xcd_barrier_complete(bar, b.x, nloc, nx); b.st[0] = nloc; b.st[1] = nx; }
    const unsigned old = xb_add(&bar[XB_XSUB(b.x)], 1u);
    const unsigned gen = old / nloc;
    if (old + 1u == (gen + 1u) * nloc) {
      __builtin_amdgcn_fence(__ATOMIC_RELEASE, "agent");
      asm volatile("s_waitcnt vmcnt(0)" ::: "memory");
      const unsigned og = xb_add(&bar[XB_TOP], 1u);
      const unsigned tg = og / nx;
      if (og + 1u == (tg + 1u) * nx) xb_add(&bar[XB_TOPGEN], 1u);
      else XB_SPIN(xb_ld(&bar[XB_TOPGEN]) == tg, bar);
      __builtin_amdgcn_fence(__ATOMIC_ACQUIRE, "agent");
      xb_add(&bar[XB_XGEN(b.x)], 1u);
      asm volatile("s_waitcnt vmcnt(0)" ::: "memory");
    } else {
      XB_SPIN(xb_ld(&bar[XB_XGEN(b.x)]) == gen, bar);
      __builtin_amdgcn_fence(__ATOMIC_ACQUIRE, "agent");
      asm volatile("s_waitcnt vmcnt(0)" ::: "memory");
    }
  }
  __syncthreads();
}

constexpr int BM = 256, BK = 64, HALF = 128, HTB = HALF * BK * 2;
DI int lds_byte(int r, int c) { int st = (r >> 4) * 2 + (c >> 5), rr = r & 15, cc = c & 31, ob = rr * 64 + cc * 2; return st * 1024 + (ob ^ (((ob >> 9) & 1) << 5)); }
DI void stage_rc(int b, int& R, int& C) { int st = b / 1024, sb = b % 1024, swz = sb ^ (((sb >> 9) & 1) << 5); R = (st >> 1) * 16 + swz / 64; C = (st & 1) * 32 + (swz % 64) / 2; }
DI int perm32(int rho) { const int n = rho >> 4, i = rho & 15; return 8 * (i >> 2) + 4 * n + (i & 3); }
struct GUnit { const char* a; const char* b; int rowbase, colbase, mode; };

DI void st8(bf16_t* dst, const f32x4 a, const f32x4 b) {
  u32x4 w; w.x = pk_bf16(a[0], a[1]); w.y = pk_bf16(a[2], a[3]); w.z = pk_bf16(b[0], b[1]); w.w = pk_bf16(b[2], b[3]);
  *(u32x4*)dst = w;
}
DI void cv8(const u32x4 a, f32x4& lo, f32x4& hi) { lo = (f32x4){bflo(a.x), bfhi(a.x), bflo(a.y), bfhi(a.y)}; hi = (f32x4){bflo(a.z), bfhi(a.z), bflo(a.w), bfhi(a.w)}; }

template <int MS>
DI void epi_regs(const Params& P, const GUnit& u, f32x4 (&acc)[2][2][4][2], int wr, int wc, int fr, int fq) {
  const int mode = u.mode;
  const int rb = u.rowbase + 64 * wr + fr, cb = u.colbase + 64 * wc + 8 * fq;
  if ((MS & 1) && (mode == 0 || mode == 1 || mode == 5 || mode == 6 || mode == 4)) {
#pragma unroll
    for (int ai = 0; ai < 2; ++ai)
#pragma unroll
      for (int m = 0; m < 4; ++m)
#pragma unroll
        for (int bj = 0; bj < 2; ++bj) {
          const int row = rb + 128 * ai + 16 * m, col = cb + 32 * bj;
          f32x4 v0 = acc[ai][bj][m][0], v1 = acc[ai][bj][m][1];
          if (mode == 1 || mode == 5) {
#pragma unroll
            for (int j = 0; j < 4; ++j) { v0[j] = siluf_(v0[j]); v1[j] = siluf_(v1[j]); }
          }
          bf16_t* dst;
          if (mode == 0) dst = P.U + (size_t)row * 512 + col;
          else if (mode == 1) dst = P.Zs + (size_t)row * 512 + (col - 512);
          else if (mode == 5) dst = P.Za + (size_t)row * 512 + (col - 2560);
          else if (mode == 6) dst = P.PP + (size_t)row * 1024 + col;
          else dst = P.Vt + ((size_t)((col >> 12) * 512 + row)) * 4096 + (col & 4095);
          st8(dst, v0, v1);
        }
  } else if ((MS & 2) && (mode == 2 || mode == 3)) {
    const float* w = (mode == 2) ? P.qnw : P.knw;
    const f32x4 w00 = *(const f32x4*)(w + 8 * fq), w01 = *(const f32x4*)(w + 8 * fq + 4), w10 = *(const f32x4*)(w + 32 + 8 * fq), w11 = *(const f32x4*)(w + 32 + 8 * fq + 4);
    const float sgn = (fq == 0) ? -1.0f : 1.0f;
    const float osc = (mode == 2) ? (0.125f * LOG2E) : 1.0f;
#pragma unroll
    for (int ai = 0; ai < 2; ++ai)
#pragma unroll
      for (int m = 0; m < 4; ++m) {
        const int row = rb + 128 * ai + 16 * m;
        f32x4 a0 = acc[ai][0][m][0], a1 = acc[ai][0][m][1], b0 = acc[ai][1][m][0], b1 = acc[ai][1][m][1];
        float ss = 0.f;
#pragma unroll
        for (int j = 0; j < 4; ++j) ss += a0[j] * a0[j] + a1[j] * a1[j] + b0[j] * b0[j] + b1[j] * b1[j];
        ss += __shfl_xor(ss, 16); ss += __shfl_xor(ss, 32);
        const float rs = rsqrtf(ss * (1.0f / 64.0f) + 1e-6f);
        a0 = a0 * rs * w00; a1 = a1 * rs * w01; b0 = b0 * rs * w10; b1 = b1 * rs * w11;
        f32x4 p0, p1;
#pragma unroll
        for (int j = 0; j < 4; ++j) { p0[j] = __shfl_xor(a0[j], 16); p1[j] = __shfl_xor(a1[j], 16); }
        if (fq < 2) {
          const f32x4* rt = (const f32x4*)(P.rope + (size_t)row * 16);
          const f32x4 t0 = rt[0], t1 = rt[1], t2 = rt[2], t3 = rt[3];
          a0[0] = a0[0] * t0[0] + sgn * p0[0] * t0[1]; a0[1] = a0[1] * t0[2] + sgn * p0[1] * t0[3];
          a0[2] = a0[2] * t1[0] + sgn * p0[2] * t1[1]; a0[3] = a0[3] * t1[2] + sgn * p0[3] * t1[3];
          a1[0] = a1[0] * t2[0] + sgn * p1[0] * t2[1]; a1[1] = a1[1] * t2[2] + sgn * p1[1] * t2[3];
          a1[2] = a1[2] * t3[0] + sgn * p1[2] * t3[1]; a1[3] = a1[3] * t3[2] + sgn * p1[3] * t3[3];
        }
        a0 = a0 * osc; a1 = a1 * osc; b0 = b0 * osc; b1 = b1 * osc;
        bf16_t* dst = ((mode == 2) ? P.Qb : P.Kb) + (size_t)row * 512 + (cb - ((mode == 2) ? 1024 : 1536));
        st8(dst, a0, a1); st8(dst + 32, b0, b1);
      }
  } else if ((MS & 4) && mode == 7) {
#pragma unroll
    for (int ai = 0; ai < 2; ++ai) {
      u32x4 yg[4][2], zs[4][2];
#pragma unroll
      for (int m = 0; m < 4; ++m)
#pragma unroll
        for (int bj = 0; bj < 2; ++bj) { const size_t o = (size_t)(rb + 128 * ai + 16 * m) * 512 + cb + 32 * bj; yg[m][bj] = *(const u32x4*)(P.Yg + o); zs[m][bj] = *(const u32x4*)(P.Zs + o); }
#pragma unroll
      for (int m = 0; m < 4; ++m)
#pragma unroll
        for (int bj = 0; bj < 2; ++bj) {
          const int row = rb + 128 * ai + 16 * m, col = cb + 32 * bj;
          const f32x4 g0 = *(const f32x4*)(P.glu_b + col), g1 = *(const f32x4*)(P.glu_b + col + 4);
          f32x4 y0, y1, z0, z1; cv8(yg[m][bj], y0, y1); cv8(zs[m][bj], z0, z1);
          f32x4 v0 = acc[ai][bj][m][0], v1 = acc[ai][bj][m][1];
#pragma unroll
          for (int j = 0; j < 4; ++j) { v0[j] = y0[j] * sigmoidf_(v0[j] + g0[j]) * z0[j]; v1[j] = y1[j] * sigmoidf_(v1[j] + g1[j]) * z1[j]; }
          st8(P.Ycat + (size_t)row * 1024 + col, v0, v1);
        }
    }
  } else if ((MS & 8) && mode == 8) {
#pragma unroll
    for (int ai = 0; ai < 2; ++ai)
#pragma unroll
      for (int mh = 0; mh < 2; ++mh) {
        f32x4 xv[2][2][2];
#pragma unroll
        for (int mm = 0; mm < 2; ++mm)
#pragma unroll
          for (int bj = 0; bj < 2; ++bj) { const size_t o = (size_t)(rb + 128 * ai + 16 * (2 * mh + mm)) * 1024 + cb + 32 * bj; xv[mm][bj][0] = *(const f32x4*)(P.x + o); xv[mm][bj][1] = *(const f32x4*)(P.x + o + 4); }
#pragma unroll
        for (int mm = 0; mm < 2; ++mm)
#pragma unroll
          for (int bj = 0; bj < 2; ++bj) { const int m = 2 * mh + mm; const size_t o = (size_t)(rb + 128 * ai + 16 * m) * 1024 + cb + 32 * bj;
            st8(P.X1b + o, acc[ai][bj][m][0] + xv[mm][bj][0], acc[ai][bj][m][1] + xv[mm][bj][1]); }
      }
  } else if ((MS & 16) && mode == 9) {
#pragma unroll
    for (int ai = 0; ai < 2; ++ai) {
      u32x4 xb[4][2], pp[4][2];
#pragma unroll
      for (int m = 0; m < 4; ++m)
#pragma unroll
        for (int bj = 0; bj < 2; ++bj) { const size_t o = (size_t)(rb + 128 * ai + 16 * m) * 1024 + cb + 32 * bj; xb[m][bj] = *(const u32x4*)(P.X1b + o); pp[m][bj] = *(const u32x4*)(P.PP + o); }
#pragma unroll
      for (int m = 0; m < 4; ++m)
#pragma unroll
        for (int bj = 0; bj < 2; ++bj) {
          const size_t o = (size_t)(rb + 128 * ai + 16 * m) * 1024 + cb + 32 * bj;
          f32x4 x0, x1, q0, q1; cv8(xb[m][bj], x0, x1); cv8(pp[m][bj], q0, q1);
          const f32x4 v0 = acc[ai][bj][m][0], v1 = acc[ai][bj][m][1];
#pragma unroll
          for (int j = 0; j < 4; ++j) { x0[j] += sigmoidf_(v0[j]) * q0[j]; x1[j] += sigmoidf_(v1[j]) * q1[j]; }
          *(f32x4*)(P.out + o) = x0; *(f32x4*)(P.out + o + 4) = x1;
        }
    }
  }
}

template <int K, int MS, class Src>
__device__ __forceinline__ void gemm_stream(const Params& P, const Src& S) {
  extern __shared__ __attribute__((aligned(16))) unsigned char lds[];
  int tid = threadIdx.x; asm volatile("" : "+v"(tid));
  const int wid = __builtin_amdgcn_readfirstlane(tid >> 6), lane = tid & 63, wr = wid >> 2, wc = wid & 3, fr = lane & 15, fq = lane >> 4;
  constexpr int nt = K / BK;
  unsigned voffA[2], voffB[2];
#pragma unroll
  for (int i = 0; i < 2; ++i) { int R, C; stage_rc(tid * 16 + i * 8192, R, C); const int Rb = 64 * (R >> 5) + perm32(R & 31);
    voffA[i] = (unsigned)(R * K + C) * 2u; voffB[i] = (unsigned)(Rb * K + C) * 2u; }
  constexpr size_t kstep = (size_t)BK * 2, hstepA = (size_t)HALF * K * 2, hstepB = (size_t)32 * K * 2;
  const int aoff = lds_byte(wr * 64 + fr, fq * 8), boff = lds_byte(wc * 32 + fr, fq * 8);
#define GSA(b, h) (((b) * 2 + (h)) * HTB)
#define GSB(b, h) ((4 + (b) * 2 + (h)) * HTB)
#define GSTAGE(bufoff, gbase, voff) do { _Pragma("unroll") for (int _i = 0; _i < 2; ++_i) \
    __builtin_amdgcn_global_load_lds((const unsigned*)((const char*)(gbase) + (voff)[_i]), (LAS unsigned*)(lds + (bufoff) + tid * 16 + _i * 8192), 16, 0, 0); } while (0)
#define GLDA(dst, b, h) do { _Pragma("unroll") for (int m = 0; m < 4; ++m) _Pragma("unroll") for (int k = 0; k < 2; ++k) dst[m][k] = *(const bf16x8*)(lds + GSA(b, h) + aoff + m * 2048 + k * 1024); } while (0)
#define GLDB(dst, b, h) do { _Pragma("unroll") for (int n = 0; n < 2; ++n) _Pragma("unroll") for (int k = 0; k < 2; ++k) dst[n][k] = *(const bf16x8*)(lds + GSB(b, h) + boff + n * 2048 + k * 1024); } while (0)
#define GMMA(ai, bj, At_, Bt_) do { __builtin_amdgcn_s_setprio(1); _Pragma("unroll") for (int m = 0; m < 4; ++m) _Pragma("unroll") for (int n = 0; n < 2; ++n) _Pragma("unroll") for (int k = 0; k < 2; ++k) \
    acc[ai][bj][m][n] = __builtin_amdgcn_mfma_f32_16x16x32_bf16(Bt_[n][k], At_[m][k], acc[ai][bj][m][n], 0, 0, 0); __builtin_amdgcn_s_setprio(0); } while (0)
#define GWAIT_V(n) asm volatile("s_waitcnt vmcnt(" #n ")" ::: "memory")
#define GWAIT_L(n) asm volatile("s_waitcnt lgkmcnt(" #n ")" ::: "memory")
#define GBAR __builtin_amdgcn_s_barrier()
#define GSCHED __builtin_amdgcn_sched_barrier(0)
  GUnit cur, nxt; int ui = 0;
  if (!S.get(0, cur)) return;
  f32x4 acc[2][2][4][2];
#pragma unroll
  for (int a = 0; a < 2; ++a)
#pragma unroll
    for (int b = 0; b < 2; ++b)
#pragma unroll
      for (int m = 0; m < 4; ++m)
#pragma unroll
        for (int n = 0; n < 2; ++n) acc[a][b][m][n] = (f32x4){0.f, 0.f, 0.f, 0.f};
  bf16x8 At[4][2], B0[2][2], B1[2][2];
  const char* cA = cur.a; const char* cB = cur.b;
  __syncthreads();
#ifndef G_SP2
#define G_SP2 1
#endif
#if G_SP2
  GSTAGE(GSB(0, 0), cB, voffB); GSTAGE(GSB(0, 1), cB + hstepB, voffB); GSTAGE(GSA(0, 0), cA, voffA); GSTAGE(GSA(0, 1), cA + hstepA, voffA);
  if (wr == 1) GBAR;
  GWAIT_V(2); GBAR;
  GSTAGE(GSB(1, 0), cB + kstep, voffB); GSTAGE(GSA(1, 0), cA + kstep, voffA); GSTAGE(GSB(1, 1), cB + hstepB + kstep, voffB);
  GWAIT_V(6); GBAR;
#else
  GSTAGE(GSB(0, 0), cB, voffB); GSTAGE(GSA(0, 0), cA, voffA); GSTAGE(GSB(0, 1), cB + hstepB, voffB); GSTAGE(GSA(0, 1), cA + hstepA, voffA);
  if (wr == 1) GBAR;
  GWAIT_V(4); GBAR;
  GSTAGE(GSB(1, 0), cB + kstep, voffB); GSTAGE(GSA(1, 0), cA + kstep, voffA); GSTAGE(GSB(1, 1), cB + hstepB + kstep, voffB);
  GWAIT_V(6); GBAR;
#endif
  for (;;) {
    const bool has_next = S.get(ui + 1, nxt);
    const char* nA = has_next ? nxt.a : cA; const char* nB = has_next ? nxt.b : cB;
#pragma unroll 1
    for (int t = 0; t < nt; t += 2) {
      const bool last = (t == nt - 2);
      const char* a1 = cA + (size_t)(t + 1) * kstep;
      const char* a2 = last ? nA : cA + (size_t)(t + 2) * kstep; const char* b2 = last ? nB : cB + (size_t)(t + 2) * kstep;
      const char* a3 = a2 + kstep; const char* b3 = b2 + kstep;
#if G_SP2
      GLDB(B0, 0, 0); GLDB(B1, 0, 1); GSCHED; GLDA(At, 0, 0); GSTAGE(GSA(1, 1), a1 + hstepA, voffA);
      GWAIT_V(8); GWAIT_L(0); GBAR; GMMA(0, 0, At, B0); GMMA(0, 1, At, B1); GBAR; GSCHED;
      GLDA(At, 0, 1); GSTAGE(GSB(0, 0), b2, voffB); GSTAGE(GSB(0, 1), b2 + hstepB, voffB); GSTAGE(GSA(0, 0), a2, voffA);
      GWAIT_V(8); GWAIT_L(0); GBAR; GMMA(1, 0, At, B0); GMMA(1, 1, At, B1); GBAR; GSCHED;
      GLDB(B0, 1, 0); GLDB(B1, 1, 1); GSCHED; GLDA(At, 1, 0); GSTAGE(GSA(0, 1), a2 + hstepA, voffA);
      GWAIT_V(8); GWAIT_L(0); GBAR; GMMA(0, 0, At, B0); GMMA(0, 1, At, B1); GBAR; GSCHED;
      GLDA(At, 1, 1); GSTAGE(GSB(1, 0), b3, voffB); GSTAGE(GSB(1, 1), b3 + hstepB, voffB); GSTAGE(GSA(1, 0), a3, voffA);
      GWAIT_V(8); GWAIT_L(0); GBAR; GMMA(1, 0, At, B0); GMMA(1, 1, At, B1); GBAR; GSCHED;
#else
      GLDB(B0, 0, 0); GSCHED; GLDA(At, 0, 0); GSTAGE(GSA(1, 1), a1 + hstepA, voffA);
      GWAIT_L(8); GBAR; GWAIT_L(0); GMMA(0, 0, At, B0); GBAR; GSCHED;
      GLDB(B1, 0, 1); GSTAGE(GSB(0, 0), b2, voffB);
      GBAR; GWAIT_L(0); GMMA(0, 1, At, B1); GBAR;
      GLDA(At, 0, 1); GSTAGE(GSA(0, 0), a2, voffA);
      GBAR; GWAIT_L(0); GMMA(1, 0, At, B0); GBAR; GSCHED;
      GSTAGE(GSB(0, 1), b2 + hstepB, voffB);
      GWAIT_V(6); GBAR; GMMA(1, 1, At, B1); GBAR;
      GLDB(B0, 1, 0); GSCHED; GLDA(At, 1, 0); GSTAGE(GSA(0, 1), a2 + hstepA, voffA);
      GWAIT_L(8); GBAR; GWAIT_L(0); GMMA(0, 0, At, B0); GBAR; GSCHED;
      GLDB(B1, 1, 1); GSTAGE(GSB(1, 0), b3, voffB);
      GBAR; GWAIT_L(0); GMMA(0, 1, At, B1); GBAR;
      GLDA(At, 1, 1); GSTAGE(GSA(1, 0), a3, voffA);
      GBAR; GWAIT_L(0); GMMA(1, 0, At, B0); GBAR; GSCHED;
      GSTAGE(GSB(1, 1), b3 + hstepB, voffB);
      GWAIT_V(6); GBAR; GMMA(1, 1, At, B1); GBAR;
#endif
    }
#ifndef G_ALIGN
#define G_ALIGN 1
#endif
    if (G_ALIGN) { if (wr == 0) GBAR; }
    epi_regs<MS>(P, cur, acc, wr, wc, fr, fq);
    if (!has_next) break;
#pragma unroll
    for (int a = 0; a < 2; ++a)
#pragma unroll
      for (int b = 0; b < 2; ++b)
#pragma unroll
        for (int m = 0; m < 4; ++m)
#pragma unroll
          for (int n = 0; n < 2; ++n) acc[a][b][m][n] = (f32x4){0.f, 0.f, 0.f, 0.f};
    cur = nxt; cA = nA; cB = nB; ++ui;
    if (G_ALIGN) { if (wr == 1) GBAR; }
  }
  GWAIT_V(0);
  if (!G_ALIGN) { if (wr == 0) GBAR; }
  GBAR;
}

DI bool tile_order(int L, int nM, int nN, int& pm, int& pn) {
  const int nwg = nM * nN; if (L >= nwg) return false;
  int wgid = L; { const int q = nwg / 8, r = nwg % 8, xcd = wgid % 8, off = wgid / 8; wgid = (xcd < r ? xcd * (q + 1) : r * (q + 1) + (xcd - r) * q) + off; }
  const int nig = 8 * nN, gid = wgid / nig, fm = gid * 8, gsz = (nM - fm) < 8 ? (nM - fm) : 8;
  pm = fm + ((wgid % nig) % gsz); pn = (wgid % nig) / gsz; return true;
}

DI void transpose_w(const float* __restrict__ src, bf16_t* __restrict__ dst, int K, int N, int gtid, int gthreads) {
  const int total = (K / 8) * N;
  for (int idx = gtid; idx < total; idx += gthreads) {
    const int n = idx % N, k0 = (idx / N) * 8;
    float f[8];
#pragma unroll
    for (int j = 0; j < 8; ++j) f[j] = src[(size_t)(k0 + j) * N + n];
    u32x4 w; w.x = pk_bf16(f[0], f[1]); w.y = pk_bf16(f[2], f[3]); w.z = pk_bf16(f[4], f[5]); w.w = pk_bf16(f[6], f[7]);
    *(u32x4*)(dst + (size_t)n * K + k0) = w;
  }
}
__device__ void phase0(const Params& P, int bid, int nb) {
  const int tid = threadIdx.x, lane = tid & 63, wid = tid >> 6;
  const int gtid = bid * NTHR + tid, gthreads = nb * NTHR;
  transpose_w(P.w_in, P.WtIn, 1024, 3072, gtid, gthreads);
  transpose_w(P.glu_w, P.WtGlu, 512, 512, gtid, gthreads);
  transpose_w(P.w_out, P.WtOut, 1024, 1024, gtid, gthreads);
  transpose_w(P.wp, P.WtP, 256, 1024, gtid, gthreads);
  transpose_w(P.wg, P.WtG, 1024, 1024, gtid, gthreads);
  for (int idx = gtid; idx < NTOK * 8; idx += gthreads) {
    const int tok = idx >> 3, i = idx & 7;
    const float invf = exp2f(-(float)i * 0.125f * 18.931568569324174f);
    const float ang = (float)P.pos[tok] * invf;
    double t = (double)ang * 0.15915494309189535; t -= floor(t);
    const float tf = (float)t;
    P.rope[(size_t)idx * 2] = __builtin_amdgcn_cosf(tf); P.rope[(size_t)idx * 2 + 1] = __builtin_amdgcn_sinf(tf);
  }
  for (int idx0 = gtid; idx0 < NTOK * 256 / 8; idx0 += gthreads * 4) {
    f32x4 a[4], b[4];
#pragma unroll
    for (int u = 0; u < 4; ++u) { const int idx = idx0 + u * gthreads; if (idx < NTOK * 256 / 8) { a[u] = *(const f32x4*)(P.p + (size_t)idx * 8); b[u] = *(const f32x4*)(P.p + (size_t)idx * 8 + 4); } }
#pragma unroll
    for (int u = 0; u < 4; ++u) { const int idx = idx0 + u * gthreads; if (idx < NTOK * 256 / 8) {
      u32x4 w; w.x = pk_bf16(a[u][0], a[u][1]); w.y = pk_bf16(a[u][2], a[u][3]); w.z = pk_bf16(b[u][0], b[u][1]); w.w = pk_bf16(b[u][2], b[u][3]);
      *(u32x4*)(P.Pb + (size_t)idx * 8) = w; } }
  }
  for (int row = (bid * 8 + wid) * 4; row < NTOK; row += nb * 32) {
    f32x4 v[4][4]; float ss[4] = {0.f, 0.f, 0.f, 0.f};
#pragma unroll
    for (int rr = 0; rr < 4; ++rr)
#pragma unroll
      for (int i = 0; i < 4; ++i) v[rr][i] = *(const f32x4*)(P.x + (size_t)(row + rr) * 1024 + i * 256 + lane * 4);
#pragma unroll
    for (int rr = 0; rr < 4; ++rr)
#pragma unroll
      for (int i = 0; i < 4; ++i) ss[rr] += v[rr][i][0] * v[rr][i][0] + v[rr][i][1] * v[rr][i][1] + v[rr][i][2] * v[rr][i][2] + v[rr][i][3] * v[rr][i][3];
#pragma unroll
    for (int o = 1; o < 64; o <<= 1) {
#pragma unroll
      for (int rr = 0; rr < 4; ++rr) ss[rr] += __shfl_xor(ss[rr], o);
    }
#pragma unroll
    for (int rr = 0; rr < 4; ++rr) {
      const float rs = rsqrtf(ss[rr] * (1.0f / 1024.0f) + 1e-6f);
#pragma unroll
      for (int i = 0; i < 4; ++i) {
        const f32x4 w = *(const f32x4*)(P.norm_w + i * 256 + lane * 4);
        u32x2 o; o.x = pk_bf16(v[rr][i][0] * rs * w[0], v[rr][i][1] * rs * w[1]); o.y = pk_bf16(v[rr][i][2] * rs * w[2], v[rr][i][3] * rs * w[3]);
        *(u32x2*)(P.Hb + (size_t)(row + rr) * 1024 + i * 256 + lane * 4) = o;
      }
    }
  }
}

struct SrcIn { const Params* P; int bid, nb;
  DI bool get(int ui, GUnit& u) const {
    int pm, pn; if (!tile_order(ui * nb + bid, 128, 12, pm, pn)) return false;
    const bool isv = (pn == 8 || pn == 9);
    u.a = (const char*)(isv ? (P->WtIn + (size_t)(2048 + (pn - 8) * 256) * 1024) : (P->Hb + (size_t)pm * 256 * 1024));
    u.b = (const char*)(isv ? (P->Hb + (size_t)pm * 256 * 1024) : (P->WtIn + (size_t)pn * 256 * 1024));
    u.rowbase = isv ? (pn - 8) * 256 : pm * 256; u.colbase = isv ? pm * 256 : pn * 256;
    u.mode = (pn < 2) ? 0 : (pn < 4) ? 1 : (pn < 6) ? 2 : (pn < 8) ? 3 : isv ? 4 : 5; return true; } };
struct SrcPle { const Params* P; int bid, nb;
  DI bool get(int ui, GUnit& u) const {
    int pm, pn; if (!tile_order(ui * nb + bid, 128, 4, pm, pn)) return false;
    u.a = (const char*)(P->Pb + (size_t)pm * 256 * 256); u.b = (const char*)(P->WtP + (size_t)pn * 256 * 256); u.rowbase = pm * 256; u.colbase = pn * 256; u.mode = 6; return true; } };
struct SrcN1024 { const bf16_t* A; const bf16_t* B; int mode, bid, nb;
  DI bool get(int ui, GUnit& u) const {
    int pm, pn; if (!tile_order(ui * nb + bid, 128, 4, pm, pn)) return false;
    u.a = (const char*)(A + (size_t)pm * 256 * 1024); u.b = (const char*)(B + (size_t)pn * 256 * 1024); u.rowbase = pm * 256; u.colbase = pn * 256; u.mode = mode; return true; } };
struct SrcGlu { const Params* P; int bid, nb;
  DI bool get(int ui, GUnit& u) const {
    int pm, pn; if (!tile_order(ui * nb + bid, 128, 2, pm, pn)) return false;
    u.a = (const char*)(P->Yg + (size_t)pm * 256 * 512); u.b = (const char*)(P->WtGlu + (size_t)pn * 256 * 512); u.rowbase = pm * 256; u.colbase = pn * 256; u.mode = 7; return true; } };
__device__ void phase1(const Params& P, int bid, int nb) { SrcIn s{&P, bid, nb}; gemm_stream<1024, 3>(P, s); }

__device__ void phase_ssm_naive(const Params& P, int bid, int nb) {
  extern __shared__ __attribute__((aligned(16))) float smf[];
  float* cre = smf;
  float* cim = smf + 1024;
  float* xs = smf + 2048;
  float* us = smf + 4096;
  const int tid = threadIdx.x;
  for (int item = bid; item < 256; item += nb) {
    const int b = item >> 5, g = item & 31;
    __syncthreads();
    for (int i = tid; i < 1024; i += NTHR) { cre[i] = P.c_re[g * 1024 + i]; cim[i] = P.c_im[g * 1024 + i]; }
    float ar = 0.f, ai = 0.f, bbr[16], bbi[16], xr = 0.f, xi = 0.f;
    if (tid < 64) {
      const int n = tid;
      const float lr = P.lam_re[g * 64 + n], li = P.lam_im[g * 64 + n], dt = __expf(P.log_dt[g]);
      const float mag = __expf(lr * dt);
      double tt = (double)(li * dt) * 0.15915494309189535; tt -= floor(tt);
      ar = mag * __builtin_amdgcn_cosf((float)tt); ai = mag * __builtin_amdgcn_sinf((float)tt);
      const float nr = ar - 1.0f, ni = ai, den = lr * lr + li * li;
      const float cr = (nr * lr + ni * li) / den, ci = (ni * lr - nr * li) / den;
#pragma unroll
      for (int q = 0; q < 16; ++q) { const float br = P.b_re[(g * 64 + n) * 16 + q], bi = P.b_im[(g * 64 + n) * 16 + q]; bbr[q] = cr * br - ci * bi; bbi[q] = cr * bi + ci * br; }
    }
    for (int t0 = 0; t0 < SEQ; t0 += 16) {
      __syncthreads();
      if (tid < 256) us[tid] = bf2f(P.U[(size_t)(b * SEQ + t0 + (tid >> 4)) * 512 + g * 16 + (tid & 15)]);
      __syncthreads();
      if (tid < 64) {
#pragma unroll 1
        for (int tau = 0; tau < 16; ++tau) {
          float br = 0.f, bi = 0.f;
#pragma unroll
          for (int q = 0; q < 16; ++q) { const float u = us[tau * 16 + q]; br += bbr[q] * u; bi += bbi[q] * u; }
          const float nxr = ar * xr - ai * xi + br, nxi = ar * xi + ai * xr + bi; xr = nxr; xi = nxi;
          xs[(tau * 64 + tid) * 2] = xr; xs[(tau * 64 + tid) * 2 + 1] = xi;
        }
      }
      __syncthreads();
      if (tid < 256) {
        const int tau = tid >> 4, pch = tid & 15; float y = 0.f;
        for (int n = 0; n < 64; ++n) y += cre[pch * 64 + n] * xs[(tau * 64 + n) * 2] - cim[pch * 64 + n] * xs[(tau * 64 + n) * 2 + 1];
        y += P.ssm_d[g * 16 + pch] * us[tid];
        y = gelu_tanh(y);
        P.Yg[(size_t)(b * SEQ + t0 + tau) * 512 + g * 16 + pch] = (bf16_t)(pk_bf16(y, 0.f) & 0xffffu);
      }
    }
  }
  __syncthreads();
}

__device__ void phase_attn_naive(const Params& P, int bid, int nb) {
  extern __shared__ __attribute__((aligned(16))) float smf[];
  const int tid = threadIdx.x, lane = tid & 63, wid = tid >> 6;
  float* pl = smf + wid * 4224;
  float* qs = pl + 4096;
  float mq = 0.f, mk = 0.f, s1 = 0.f, s2 = 0.f;
  { const float a = fabsf(P.qnw[lane]), b = fabsf(P.knw[lane]); mq = a; mk = b; s1 = P.lq1[lane] * P.lk1[lane]; s2 = P.lq2[lane] * P.lk2[lane];
#pragma unroll
    for (int o = 1; o < 64; o <<= 1) { mq = fmaxf(mq, __shfl_xor(mq, o)); mk = fmaxf(mk, __shfl_xor(mk, o)); s1 += __shfl_xor(s1, o); s2 += __shfl_xor(s2, o); } }
  const float lam = __expf(s1) - __expf(s2) + 0.2f;
  const float mb = 8.0f * mq * mk * LOG2E;
  for (int item = bid * 8 + wid; item < 8 * 4 * SEQ; item += nb * 8) {
    const int i = item & 4095, h = (item >> 12) & 3, b = item >> 14;
    const size_t tok = (size_t)b * SEQ + i;
    float o[2][2], l[2];
#pragma unroll
    for (int c = 0; c < 2; ++c) {
      asm volatile("s_waitcnt lgkmcnt(0)" ::: "memory");
      qs[lane] = bf2f(P.Qb[tok * 512 + h * 128 + c * 64 + lane]);
      asm volatile("s_waitcnt lgkmcnt(0)" ::: "memory");
      float ls = 0.f;
      for (int k0 = 0; k0 <= i; k0 += 64) {
        const int key = k0 + lane; float pv = 0.f;
        if (key <= i) {
          const bf16_t* kr = P.Kb + ((size_t)b * SEQ + key) * 512 + h * 128 + c * 64; float s = 0.f;
#pragma unroll
          for (int d8 = 0; d8 < 8; ++d8) { const u32x4 kw = *(const u32x4*)(kr + d8 * 8); const f32x4 qa = *(const f32x4*)(qs + d8 * 8), qb = *(const f32x4*)(qs + d8 * 8 + 4);
            s += bflo(kw.x) * qa[0] + bfhi(kw.x) * qa[1] + bflo(kw.y) * qa[2] + bfhi(kw.y) * qa[3] + bflo(kw.z) * qb[0] + bfhi(kw.z) * qb[1] + bflo(kw.w) * qb[2] + bfhi(kw.w) * qb[3]; }
          pv = exp2f(s - mb);
        }
        pl[key] = pv; ls += pv;
      }
#pragma unroll
      for (int of = 1; of < 64; of <<= 1) ls += __shfl_xor(ls, of);
      l[c] = ls;
      asm volatile("s_waitcnt lgkmcnt(0)" ::: "memory");
      const int nk = ((i >> 6) + 1) * 64;
      float o0 = 0.f, o1 = 0.f;
      const bf16_t* v0 = P.Vt + ((size_t)(b * 512 + h * 128 + lane)) * 4096; const bf16_t* v1 = v0 + (size_t)64 * 4096;
      for (int k = 0; k < nk; k += 8) {
        const u32x4 a = *(const u32x4*)(v0 + k), bb = *(const u32x4*)(v1 + k); const f32x4 pa = *(const f32x4*)(pl + k), pb = *(const f32x4*)(pl + k + 4);
        o0 += bflo(a.x) * pa[0] + bfhi(a.x) * pa[1] + bflo(a.y) * pa[2] + bfhi(a.y) * pa[3] + bflo(a.z) * pb[0] + bfhi(a.z) * pb[1] + bflo(a.w) * pb[2] + bfhi(a.w) * pb[3];
        o1 += bflo(bb.x) * pa[0] + bfhi(bb.x) * pa[1] + bflo(bb.y) * pa[2] + bfhi(bb.y) * pa[3] + bflo(bb.z) * pb[0] + bfhi(bb.z) * pb[1] + bflo(bb.w) * pb[2] + bfhi(bb.w) * pb[3];
      }
      o[c][0] = o0; o[c][1] = o1;
    }
    const float r0 = o[0][0] / l[0] - lam * o[1][0] / l[1], r1 = o[0][1] / l[0] - lam * o[1][1] / l[1];
    float ss = r0 * r0 + r1 * r1;
#pragma unroll
    for (int of = 1; of < 64; of <<= 1) ss += __shfl_xor(ss, of);
    const float rs = rsqrtf(ss * (1.0f / 128.0f) + 1e-6f) * 0.8f;
    const float y0 = r0 * rs * P.subln_w[lane] * bf2f(P.Za[tok * 512 + h * 128 + lane]);
    const float y1 = r1 * rs * P.subln_w[lane + 64] * bf2f(P.Za[tok * 512 + h * 128 + 64 + lane]);
    P.Ycat[tok * 1024 + 512 + h * 128 + lane] = (bf16_t)(pk_bf16(y0, 0.f) & 0xffffu);
    P.Ycat[tok * 1024 + 512 + h * 128 + 64 + lane] = (bf16_t)(pk_bf16(y1, 0.f) & 0xffffu);
  }
  __syncthreads();
}

__device__ void phase_ssm(const Params& P, int bid, int nb) {
  extern __shared__ __attribute__((aligned(16))) unsigned char sm[];
  constexpr int XP = 288;
  int tid = threadIdx.x; asm volatile("" : "+v"(tid));
  const int lane = tid & 63, wid = __builtin_amdgcn_readfirstlane(tid >> 6), r = lane & 31, hl = lane >> 5;
  float* E = (float*)sm;
  unsigned char* xw = sm + 16384 + wid * (32 * XP);
  const int hs_r = (r >> 2) & 1, tau_r = (r & 3) + 4 * (r >> 3);
  const int pch = lane & 15, kq = lane >> 4;
  for (int item = bid; item < 256; item += nb) {
    const int b = item >> 5, g = item & 31;
    __syncthreads();
    float ar[2], ai[2], a256r[2], a256i[2];
    bf16x8 Bre[2], Bim[2], Cf[4];
    {
      const float dt = __expf(P.log_dt[g]);
#pragma unroll
      for (int sh = 0; sh < 2; ++sh) {
        const int n = r + 32 * sh;
        const float lr = P.lam_re[g * 64 + n], li = P.lam_im[g * 64 + n];
        const float mag = __expf(lr * dt);
        double tt = (double)(li * dt) * 0.15915494309189535; tt -= floor(tt);
        ar[sh] = mag * __builtin_amdgcn_cosf((float)tt); ai[sh] = mag * __builtin_amdgcn_sinf((float)tt);
        const float nr = ar[sh] - 1.0f, ni = ai[sh], den = lr * lr + li * li;
        const float cr = (nr * lr + ni * li) / den, ci = (ni * lr - nr * li) / den;
        const f32x4 br0 = *(const f32x4*)(P.b_re + (g * 64 + n) * 16 + 8 * hl), br1 = *(const f32x4*)(P.b_re + (g * 64 + n) * 16 + 8 * hl + 4);
        const f32x4 bi0 = *(const f32x4*)(P.b_im + (g * 64 + n) * 16 + 8 * hl), bi1 = *(const f32x4*)(P.b_im + (g * 64 + n) * 16 + 8 * hl + 4);
        u32x4 wr_, wi_;
        wr_.x = pk_bf16(cr * br0[0] - ci * bi0[0], cr * br0[1] - ci * bi0[1]); wr_.y = pk_bf16(cr * br0[2] - ci * bi0[2], cr * br0[3] - ci * bi0[3]);
        wr_.z = pk_bf16(cr * br1[0] - ci * bi1[0], cr * br1[1] - ci * bi1[1]); wr_.w = pk_bf16(cr * br1[2] - ci * bi1[2], cr * br1[3] - ci * bi1[3]);
        wi_.x = pk_bf16(cr * bi0[0] + ci * br0[0], cr * bi0[1] + ci * br0[1]); wi_.y = pk_bf16(cr * bi0[2] + ci * br0[2], cr * bi0[3] + ci * br0[3]);
        wi_.z = pk_bf16(cr * bi1[0] + ci * br1[0], cr * bi1[1] + ci * br1[1]); wi_.w = pk_bf16(cr * bi1[2] + ci * br1[2], cr * bi1[3] + ci * br1[3]);
        Bre[sh] = __builtin_bit_cast(bf16x8, wr_); Bim[sh] = __builtin_bit_cast(bf16x8, wi_);
        float pr = ar[sh], pi = ai[sh];
#pragma unroll
        for (int q = 0; q < 7; ++q) { const float t = pr * pr - pi * pi; pi = 2.0f * pr * pi; pr = t; }
        a256r[sh] = pr; a256i[sh] = pi;
      }
#pragma unroll
      for (int ks = 0; ks < 4; ++ks) {
        const int n0 = 16 * ks + 4 * kq;
        const f32x4 cre = *(const f32x4*)(P.c_re + (g * 16 + pch) * 64 + n0), cim = *(const f32x4*)(P.c_im + (g * 16 + pch) * 64 + n0);
        u32x4 w; w.x = pk_bf16(cre[0], -cim[0]); w.y = pk_bf16(cre[1], -cim[1]); w.z = pk_bf16(cre[2], -cim[2]); w.w = pk_bf16(cre[3], -cim[3]);
        Cf[ks] = __builtin_bit_cast(bf16x8, w);
      }
    }
    bf16x8 Df;
    { const float dsk = P.ssm_d[g * 16 + pch]; u32x4 w = {0u, 0u, 0u, 0u};
      if (kq < 2) { const int jj = pch - 8 * kq; const unsigned hv = pk_bf16(dsk, 0.f) & 0xffffu;
        if (jj >= 0 && jj < 8) { const unsigned val = (jj & 1) ? (hv << 16) : hv; if ((jj >> 1) == 0) w.x = val; else if ((jj >> 1) == 1) w.y = val; else if ((jj >> 1) == 2) w.z = val; else w.w = val; } }
      Df = __builtin_bit_cast(bf16x8, w); }
    const unsigned uaoff = (unsigned)((kq < 2) ? (256 + 16 * kq) : (16 * (kq - 2)));
    const char* ub = (const char*)(P.U + ((size_t)b * SEQ + 512 * wid) * 512 + g * 16);
    char* yb = (char*)(P.Yg + ((size_t)b * SEQ + 512 * wid) * 512 + g * 16);
    const unsigned aoff = (unsigned)(((128 * (2 * hs_r + (tau_r & 1)) + (tau_r >> 1)) * 512 + 8 * hl) * 2);
    typedef float f32x2v __attribute__((ext_vector_type(2)));
    f32x2v xr[2] = {{0.f, 0.f}, {0.f, 0.f}}, xi[2] = {{0.f, 0.f}, {0.f, 0.f}};
    f32x16 z16;
#pragma unroll
    for (int i = 0; i < 16; ++i) z16[i] = 0.f;
    bf16x8 afr[16];
#pragma unroll
    for (int t = 0; t < 16; ++t) afr[t] = *(const bf16x8*)(ub + aoff + (unsigned)(t * 8 * 512 * 2));
#pragma unroll
    for (int t = 0; t < 16; ++t) {
#pragma unroll
      for (int sh = 0; sh < 2; ++sh) {
        const f32x16 bur = __builtin_amdgcn_mfma_f32_32x32x16_bf16(afr[t], Bre[sh], z16, 0, 0, 0);
        const f32x16 bui = __builtin_amdgcn_mfma_f32_32x32x16_bf16(afr[t], Bim[sh], z16, 0, 0, 0);
#pragma unroll
        for (int j = 0; j < 8; ++j) { const f32x2v br2 = {bur[2 * j], bur[2 * j + 1]}, bi2 = {bui[2 * j], bui[2 * j + 1]};
          const f32x2v nr = ar[sh] * xr[sh] + br2 - ai[sh] * xi[sh], ni = ar[sh] * xi[sh] + bi2 + ai[sh] * xr[sh]; xr[sh] = nr; xi[sh] = ni; }
      }
    }
    const int cidx0 = 4 * wid + 2 * hl;
#pragma unroll
    for (int sh = 0; sh < 2; ++sh) {
      E[(cidx0 * 64 + r + 32 * sh) * 2] = xr[sh].x; E[(cidx0 * 64 + r + 32 * sh) * 2 + 1] = xi[sh].x;
      E[((cidx0 + 1) * 64 + r + 32 * sh) * 2] = xr[sh].y; E[((cidx0 + 1) * 64 + r + 32 * sh) * 2 + 1] = xi[sh].y;
    }
    __syncthreads();
    {
      float sr[2] = {0.f, 0.f}, si[2] = {0.f, 0.f};
#pragma unroll 1
      for (int c2 = 0; c2 < 30; ++c2) {
        if (c2 < cidx0) {
#pragma unroll
          for (int sh = 0; sh < 2; ++sh) {
            const float er = E[(c2 * 64 + r + 32 * sh) * 2], ei = E[(c2 * 64 + r + 32 * sh) * 2 + 1];
            const float nr = a256r[sh] * sr[sh] - a256i[sh] * si[sh] + er, ni = a256r[sh] * si[sh] + a256i[sh] * sr[sh] + ei; sr[sh] = nr; si[sh] = ni;
          }
        }
      }
#pragma unroll
      for (int sh = 0; sh < 2; ++sh) {
        const float e0r = xr[sh].x, e0i = xi[sh].x;
        const float s1r = a256r[sh] * sr[sh] - a256i[sh] * si[sh] + e0r, s1i = a256r[sh] * si[sh] + a256i[sh] * sr[sh] + e0i;
        xr[sh] = (f32x2v){sr[sh], s1r}; xi[sh] = (f32x2v){si[sh], s1i};
      }
    }
    {
      const f32x4 z4 = {0.f, 0.f, 0.f, 0.f};
#pragma unroll
      for (int t = 0; t < 16; ++t) {
        *(bf16x8*)(xw + (hs_r * 16 + tau_r) * XP + 256 + 16 * hl) = afr[t];
#pragma unroll
        for (int sh = 0; sh < 2; ++sh) {
          const f32x16 bur = __builtin_amdgcn_mfma_f32_32x32x16_bf16(afr[t], Bre[sh], z16, 0, 0, 0);
          const f32x16 bui = __builtin_amdgcn_mfma_f32_32x32x16_bf16(afr[t], Bim[sh], z16, 0, 0, 0);
#pragma unroll
          for (int j = 0; j < 8; ++j) {
            const f32x2v br2 = {bur[2 * j], bur[2 * j + 1]}, bi2 = {bui[2 * j], bui[2 * j + 1]};
            const f32x2v nr = ar[sh] * xr[sh] + br2 - ai[sh] * xi[sh], ni = ar[sh] * xi[sh] + bi2 + ai[sh] * xr[sh]; xr[sh] = nr; xi[sh] = ni;
            *(unsigned*)(xw + (hl * 16 + 2 * j) * XP + (r + 32 * sh) * 4) = pk_bf16(nr.x, ni.x);
            *(unsigned*)(xw + (hl * 16 + 2 * j + 1) * XP + (r + 32 * sh) * 4) = pk_bf16(nr.y, ni.y);
          }
        }
        asm volatile("s_waitcnt lgkmcnt(0)" ::: "memory");
#pragma unroll
        for (int mt = 0; mt < 2; ++mt) {
          f32x4 acc = z4;
#pragma unroll
          for (int ks = 0; ks < 4; ++ks) {
            const bf16x8 xa = *(const bf16x8*)(xw + (mt * 16 + pch) * XP + (32 * ks + 8 * kq) * 2);
            acc = __builtin_amdgcn_mfma_f32_16x16x32_bf16(xa, Cf[ks], acc, 0, 0, 0);
          }
          { const bf16x8 ua = *(const bf16x8*)(xw + (mt * 16 + pch) * XP + uaoff);
            acc = __builtin_amdgcn_mfma_f32_16x16x32_bf16(ua, Df, acc, 0, 0, 0); }
#pragma unroll
          for (int i = 0; i < 4; ++i) {
            const float y = gelu_tanh(acc[i]);
            *(bf16_t*)(yb + (unsigned)(((128 * (2 * mt + ((4 * kq + i) & 1)) + 8 * t + ((4 * kq + i) >> 1)) * 512 + pch) * 2)) = (bf16_t)(pk_bf16(y, 0.f) & 0xffffu);
          }
        }
        asm volatile("s_waitcnt lgkmcnt(0)" ::: "memory");
      }
    }
  }
  __syncthreads();
}

DI int pi_row(int r) { const int hh = (r >> 2) & 1, i = (r & 3) + 4 * (r >> 3); return 16 * (i >> 3) + 8 * hh + (i & 7); }
DI int crow16(int i, int hh) { return (i & 3) + 8 * (i >> 2) + 4 * hh; }
__device__ void phase_attn(const Params& P, int bid, int nb) {
  extern __shared__ __attribute__((aligned(16))) unsigned char sm[];
  constexpr int KP = 272, VP = 272, KBYTES = 128 * KP, VBYTES = 128 * VP, BUF = KBYTES + VBYTES, YOFF = BUF, YP = 272;
  int tid = threadIdx.x; asm volatile("" : "+v"(tid));
  const int lane = tid & 63, wid = __builtin_amdgcn_readfirstlane(tid >> 6), c = wid >> 2, qs = wid & 3, r = lane & 31, hl = lane >> 5;
  float mq, mk, s1, s2;
  { mq = fabsf(P.qnw[lane]); mk = fabsf(P.knw[lane]); s1 = P.lq1[lane] * P.lk1[lane]; s2 = P.lq2[lane] * P.lk2[lane];
#pragma unroll
    for (int o = 1; o < 64; o <<= 1) { mq = fmaxf(mq, __shfl_xor(mq, o)); mk = fmaxf(mk, __shfl_xor(mk, o)); s1 += __shfl_xor(s1, o); s2 += __shfl_xor(s2, o); } }
  const float lam = __expf(s1) - __expf(s2) + 0.2f;
  const float nmb = -8.0f * mq * mk * LOG2E;
  const int pir = pi_row(r);
  const int vb = (nb % 8 == 0) ? (bid % 8) * (nb / 8) + bid / 8 : bid;
  for (int pid = vb; pid < 512; pid += nb) {
    const int bh = pid >> 4, kk = pid & 15, b = bh >> 2, h = bh & 3;
#pragma unroll 1
    for (int half = 0; half < 2; ++half) {
      const int qb = half ? kk : 31 - kk, q0 = qb * 128, qw0 = q0 + 32 * qs;
      const size_t tok0 = (size_t)b * SEQ;
      bf16x8 qf[4];
#pragma unroll
      for (int ks = 0; ks < 4; ++ks) qf[ks] = *(const bf16x8*)((const char*)(P.Qb + (tok0 + qw0) * 512 + h * 128 + c * 64) + (unsigned)((r * 512 + ks * 16 + hl * 8) * 2));
      const bf16_t* kg = P.Kb + tok0 * 512 + h * 128;
      const bf16_t* vg = P.Vt + ((size_t)(b * 512 + h * 128)) * 4096;
      u32x4 st[8];
      int t3 = tid; asm volatile("" : "+v"(t3));
      const unsigned koff = (unsigned)((t3 >> 4) * 512 + (t3 & 15) * 8) * 2u, voff_ = (unsigned)((t3 >> 4) * 4096 + (t3 & 15) * 8) * 2u;
      const unsigned klds = (unsigned)((t3 >> 4) * KP + (t3 & 15) * 16), vlds = (unsigned)(KBYTES + (t3 >> 4) * VP + (t3 & 15) * 16);
      const int nst = qb + 1;
#pragma unroll
      for (int i = 0; i < 4; ++i) { st[i] = *(const u32x4*)((const char*)kg + koff + (unsigned)(i * 32 * 1024)); st[4 + i] = *(const u32x4*)((const char*)vg + voff_ + (unsigned)(i * 32 * 8192)); }
#pragma unroll
      for (int i = 0; i < 4; ++i) { *(u32x4*)(sm + klds + i * 32 * KP) = st[i]; *(u32x4*)(sm + vlds + i * 32 * VP) = st[4 + i]; }
      __syncthreads();
      f32x16 o[4];
#pragma unroll
      for (int dt = 0; dt < 4; ++dt)
#pragma unroll
        for (int i = 0; i < 16; ++i) o[dt][i] = 0.f;
      float l = 0.f;
#pragma unroll 1
      for (int stp = 0; stp < nst; ++stp) {
        const bool more = (stp + 1 < nst);
        if (more) {
#pragma unroll
          for (int i = 0; i < 4; ++i) { st[i] = *(const u32x4*)((const char*)kg + (size_t)(stp + 1) * (128 * 1024) + koff + (unsigned)(i * 32 * 1024)); st[4 + i] = *(const u32x4*)((const char*)vg + (size_t)(stp + 1) * 256 + voff_ + (unsigned)(i * 32 * 8192)); }
        }
        const unsigned char* bbuf = sm + (stp & 1) * BUF;
#pragma unroll
        for (int sub = 0; sub < 2; ++sub) {
        const int kt = 2 * stp + sub;
        if (64 * kt <= qw0 + 31) {
          const unsigned char* kbuf = bbuf + sub * 64 * KP; const unsigned char* vbuf = bbuf + KBYTES + sub * 128;
          f32x16 s[2];
#pragma unroll
          for (int i = 0; i < 16; ++i) { s[0][i] = nmb; s[1][i] = nmb; }
          __builtin_amdgcn_s_setprio(1);
#pragma unroll
          for (int ks = 0; ks < 4; ++ks) {
            const bf16x8 k0 = *(const bf16x8*)(kbuf + pir * KP + (c * 64 + ks * 16 + hl * 8) * 2);
            const bf16x8 k1 = *(const bf16x8*)(kbuf + (32 + pir) * KP + (c * 64 + ks * 16 + hl * 8) * 2);
            s[0] = __builtin_amdgcn_mfma_f32_32x32x16_bf16(k0, qf[ks], s[0], 0, 0, 0);
            s[1] = __builtin_amdgcn_mfma_f32_32x32x16_bf16(k1, qf[ks], s[1], 0, 0, 0);
          }
          __builtin_amdgcn_s_setprio(0);
          if (64 * kt + 63 > qw0) {
            asm volatile("" ::: "memory");
#pragma unroll
            for (int mt = 0; mt < 2; ++mt)
#pragma unroll
              for (int i = 0; i < 16; ++i) { const int key = 64 * kt + 32 * mt + 16 * (i >> 3) + 8 * hl + (i & 7); s[mt][i] = (key <= qw0 + r) ? s[mt][i] : -1.0e30f; }
            asm volatile("" ::: "memory");
          }
          bf16x8 pb[2][2];
#pragma unroll
          for (int mt = 0; mt < 2; ++mt) {
            float pv[16];
#pragma unroll
            for (int i = 0; i < 16; ++i) { const float e = __builtin_amdgcn_exp2f(s[mt][i]); pv[i] = e; l += e; }
#pragma unroll
            for (int sp = 0; sp < 2; ++sp) {
              u32x4 w; w.x = pk_bf16(pv[8 * sp], pv[8 * sp + 1]); w.y = pk_bf16(pv[8 * sp + 2], pv[8 * sp + 3]); w.z = pk_bf16(pv[8 * sp + 4], pv[8 * sp + 5]); w.w = pk_bf16(pv[8 * sp + 6], pv[8 * sp + 7]);
              pb[mt][sp] = __builtin_bit_cast(bf16x8, w);
            }
          }
          {
            bf16x8 vc[4], vn[4];
#pragma unroll
            for (int dt = 0; dt < 4; ++dt) vc[dt] = *(const bf16x8*)(vbuf + (32 * dt + r) * VP + (8 * hl) * 2);
#pragma unroll
            for (int g = 0; g < 4; ++g) {
              if (g < 3) {
#pragma unroll
                for (int dt = 0; dt < 4; ++dt) vn[dt] = *(const bf16x8*)(vbuf + (32 * dt + r) * VP + (16 * (g + 1) + 8 * hl) * 2);
              }
              __builtin_amdgcn_sched_barrier(0);
              __builtin_amdgcn_s_setprio(1);
#pragma unroll
              for (int dt = 0; dt < 4; ++dt) o[dt] = __builtin_amdgcn_mfma_f32_32x32x16_bf16(vc[dt], pb[g >> 1][g & 1], o[dt], 0, 0, 0);
              __builtin_amdgcn_s_setprio(0);
              __builtin_amdgcn_sched_barrier(0);
              if (g < 3) {
#pragma unroll
                for (int dt = 0; dt < 4; ++dt) vc[dt] = vn[dt];
              }
            }
          }
        }
        }
        if (more) {
          unsigned char* nb_ = sm + ((stp + 1) & 1) * BUF;
#pragma unroll
          for (int i = 0; i < 4; ++i) { *(u32x4*)(nb_ + klds + i * 32 * KP) = st[i]; *(u32x4*)(nb_ + vlds + i * 32 * VP) = st[4 + i]; }
        }
        __syncthreads();
      }
      int t4 = tid; asm volatile("" : "+v"(t4));
      const char* zab = (const char*)(P.Za + (tok0 + q0) * 512 + h * 128);
      u32x4 zaq[4];
#pragma unroll
      for (int i = 0; i < 4; ++i) { const int id = t4 + 512 * i; zaq[i] = *(const u32x4*)(zab + (unsigned)((id >> 4) * 1024 + (id & 15) * 16)); }
      l += __shfl_xor(l, 32);
      const float inv = 1.0f / l;
      float* oex = (float*)sm;
      float* ssx = (float*)(sm + YOFF + 128 * YP);
      {
#pragma unroll
        for (int dd = 0; dd < 2; ++dd)
#pragma unroll
          for (int i = 0; i < 16; ++i) {
            const float v0 = o[dd][i] * inv, v1 = o[2 + dd][i] * inv;
            oex[((c * 4 + qs) * 64 + 32 * dd + crow16(i, hl)) * 32 + r] = c ? v0 : v1;
          }
      }
      __syncthreads();
      {
        float ss = 0.f;
        float vv[2][16];
#pragma unroll
        for (int dd = 0; dd < 2; ++dd)
#pragma unroll
          for (int i = 0; i < 16; ++i) {
            const float own = (c ? o[2 + dd][i] : o[dd][i]) * inv;
            const float oth = oex[(((1 - c) * 4 + qs) * 64 + 32 * dd + crow16(i, hl)) * 32 + r];
            const float v = c ? (oth - lam * own) : (own - lam * oth);
            vv[dd][i] = v; ss += v * v;
          }
        ss += __shfl_xor(ss, 32);
        if (hl == 0) ssx[c * 128 + 32 * qs + r] = ss;
#pragma unroll
        for (int dd = 0; dd < 2; ++dd)
#pragma unroll
          for (int g = 0; g < 4; ++g) {
            const int dv0 = 64 * c + 32 * dd + 8 * g + 4 * hl;
            const f32x4 wv = *(const f32x4*)(P.subln_w + dv0);
            u32x2 w; w.x = pk_bf16(vv[dd][4 * g] * wv[0], vv[dd][4 * g + 1] * wv[1]); w.y = pk_bf16(vv[dd][4 * g + 2] * wv[2], vv[dd][4 * g + 3] * wv[3]);
            *(u32x2*)(sm + YOFF + (32 * qs + r) * YP + dv0 * 2) = w;
          }
      }
      __syncthreads();
      char* ycb = (char*)(P.Ycat + (tok0 + q0) * 1024 + 512 + h * 128);
#pragma unroll
      for (int i = 0; i < 4; ++i) {
        const int id = t4 + 512 * i, row = id >> 4, ch = id & 15;
        const u32x4 y8 = *(const u32x4*)(sm + YOFF + row * YP + ch * 16);
        const u32x4 za = zaq[i];
        const float rs = rsqrtf((ssx[row] + ssx[128 + row]) * (1.0f / 128.0f) + 1e-6f) * 0.8f;
        u32x4 w;
        w.x = pk_bf16(bflo(y8.x) * rs * bflo(za.x), bfhi(y8.x) * rs * bfhi(za.x)); w.y = pk_bf16(bflo(y8.y) * rs * bflo(za.y), bfhi(y8.y) * rs * bfhi(za.y));
        w.z = pk_bf16(bflo(y8.z) * rs * bflo(za.z), bfhi(y8.z) * rs * bfhi(za.z)); w.w = pk_bf16(bflo(y8.w) * rs * bflo(za.w), bfhi(y8.w) * rs * bfhi(za.w));
        *(u32x4*)(ycb + (unsigned)(row * 2048 + ch * 16)) = w;
      }
    }
  }
  __syncthreads();
}

__device__ void phase3(const Params& P, int bid, int nb) { SrcGlu s{&P, bid, nb}; gemm_stream<512, 4>(P, s); }
__device__ void phase4(const Params& P, int bid, int nb) {
  const bool ple_first = ((bid >> 3) & 1) != 0;
  SrcPle sp{&P, bid, nb}; SrcN1024 so{P.Ycat, P.WtOut, 8, bid, nb};
  if (ple_first) gemm_stream<256, 1>(P, sp);
  gemm_stream<1024, 8>(P, so);
  if (!ple_first) gemm_stream<256, 1>(P, sp);
}
__device__ void phase5(const Params& P, int bid, int nb) { SrcN1024 s{P.X1b, P.WtG, 9, bid, nb}; gemm_stream<1024, 16>(P, s); }

__global__ void __launch_bounds__(NTHR, 2) mega(Params P, int plo, int phi) {
  const int bid = blockIdx.x, nb = gridDim.x;
#define IN(k) (plo <= (k) && (k) < phi)
  extern __shared__ __attribute__((aligned(16))) unsigned char smk[];
  volatile LAS unsigned* xst = (volatile LAS unsigned*)(smk + LDS_BYTES);
  if (threadIdx.x < 4) xst[threadIdx.x] = 0u;
  __syncthreads();
  XcdBarrier xbar = xcd_barrier_post(P.barw, xst);
  if (plo > 1000) cg::this_grid().sync();
#define SEAM(k) do { if (IN(k) && IN((k) + 1)) xcd_barrier(xbar); } while (0)
#ifndef REP
#define REP -1
#endif
#define GS() xcd_barrier(xbar)
  if (IN(0)) { phase0(P, bid, nb); if (REP == 0) { GS(); phase0(P, bid, nb); } }
  SEAM(0);
  if (IN(1)) { phase1(P, bid, nb); if (REP == 1) { GS(); phase1(P, bid, nb); } }
  SEAM(1);
  if (IN(2)) { phase_ssm(P, bid, nb); if (REP == 2) { GS(); phase_ssm(P, bid, nb); } phase_attn(P, bid, nb); if (REP == 6) { GS(); phase_attn(P, bid, nb); } }
  SEAM(2);
  if (IN(3)) { phase3(P, bid, nb); if (REP == 3) { GS(); phase3(P, bid, nb); } }
  SEAM(3);
  if (IN(4)) { phase4(P, bid, nb); if (REP == 4) { GS(); phase4(P, bid, nb); } }
  SEAM(4);
  if (IN(5)) phase5(P, bid, nb);
  if (REP == 5) { GS(); phase4(P, bid, nb); GS(); phase5(P, bid, nb); }
}

#ifndef N_LAUNCH_MODE
#define N_LAUNCH_MODE 1
#endif

extern "C" void kernel_launch(void* const* d_in, const int* in_sizes, int n_in, void* d_out, int out_size, void* d_ws, size_t ws_size, hipStream_t stream) {
  Params P{};
  P.x = (const float*)d_in[0]; P.p = (const float*)d_in[1]; P.pos = (const int*)d_in[2];
  P.norm_w = (const float*)d_in[3]; P.w_in = (const float*)d_in[4]; P.lam_re = (const float*)d_in[5]; P.lam_im = (const float*)d_in[6];
  P.log_dt = (const float*)d_in[7]; P.b_re = (const float*)d_in[8]; P.b_im = (const float*)d_in[9]; P.c_re = (const float*)d_in[10]; P.c_im = (const float*)d_in[11];
  P.ssm_d = (const float*)d_in[12]; P.glu_w = (const float*)d_in[13]; P.glu_b = (const float*)d_in[14]; P.qnw = (const float*)d_in[15]; P.knw = (const float*)d_in[16];
  P.lq1 = (const float*)d_in[17]; P.lk1 = (const float*)d_in[18]; P.lq2 = (const float*)d_in[19]; P.lk2 = (const float*)d_in[20]; P.subln_w = (const float*)d_in[21];
  P.w_out = (const float*)d_in[22]; P.wp = (const float*)d_in[23]; P.wg = (const float*)d_in[24];
  P.out = (float*)d_out;
  char* w = (char*)d_ws; size_t off = 16384;
  P.barw = (unsigned*)d_ws;
  auto take = [&](size_t bytes) { char* r = w + off; off += (bytes + 255) & ~(size_t)255; return (bf16_t*)r; };
  P.Hb = take((size_t)NTOK * 1024 * 2); P.X1b = P.Hb;
  P.WtIn = take((size_t)3072 * 1024 * 2); P.WtGlu = take((size_t)512 * 512 * 2); P.WtOut = take((size_t)1024 * 1024 * 2);
  P.WtP = take((size_t)1024 * 256 * 2); P.WtG = take((size_t)1024 * 1024 * 2);
  P.Pb = take((size_t)NTOK * 256 * 2);
  P.U = take((size_t)NTOK * 512 * 2); P.Zs = take((size_t)NTOK * 512 * 2); P.Qb = take((size_t)NTOK * 512 * 2); P.Kb = take((size_t)NTOK * 512 * 2);
  P.Vt = take((size_t)NTOK * 512 * 2); P.Za = take((size_t)NTOK * 512 * 2); P.Yg = take((size_t)NTOK * 512 * 2);
  P.Ycat = take((size_t)NTOK * 1024 * 2); P.PP = take((size_t)NTOK * 1024 * 2);
  P.rope = (float*)take((size_t)NTOK * 16 * 4);

  static int grid_blocks = 0;
  if (!grid_blocks) {
    hipFuncSetAttribute((const void*)mega, hipFuncAttributeMaxDynamicSharedMemorySize, LDS_BYTES + 256);
    int dev = 0, cus = 0, per_cu = 0;
    hipGetDevice(&dev);
    hipDeviceGetAttribute(&cus, hipDeviceAttributeMultiprocessorCount, dev);
    hipOccupancyMaxActiveBlocksPerMultiprocessor(&per_cu, mega, NTHR, LDS_BYTES + 256);
    if (per_cu < 1) per_cu = 1;
    grid_blocks = cus;
  }
#if N_LAUNCH_MODE == 1
  hipMemsetAsync(d_ws, 0, 16384, stream);
  int plo = 0, phi = 6;
  void* args[] = {&P, &plo, &phi};
  hipError_t e = hipLaunchCooperativeKernel((void*)mega, dim3(grid_blocks), dim3(NTHR), args, LDS_BYTES + 256, stream);
  if (e != hipSuccess) fprintf(stderr, "cooperative launch failed: %s (grid %d)\n", hipGetErrorString(e), grid_blocks);
#else
  for (int ph = 0; ph < 6; ++ph) hipLaunchKernelGGL(mega, dim3(grid_blocks), dim3(NTHR), LDS_BYTES, stream, P, ph, ph + 1);
#endif
}
```
